# Optimizing an MI355X kernel written in HIP

```python
import jax, jax.numpy as jnp
from jax import lax
import numpy as np


D_MODEL = 1024
BATCH = 2
SEQ = 16384
DEPTH = 2

N_MEM = 256
EPS = 1e-6
ROPE_THETA = 10000.0
ATT_HEADS = 8
ATT_KV_HEADS = 2
ATT_HEAD_DIM = D_MODEL // ATT_HEADS
IDX_HEADS = 4
IDX_DIM = 64
TOPK_MAX = 256
Q_BLOCK = 128
GDN_HEADS = 8
GDN_DK = 128
GDN_DV = 128
CONV_K = 4
CHUNK = 64
XATT_HEADS = 4
XATT_HEAD_DIM = D_MODEL // XATT_HEADS
FF_DIM = -(-8 * D_MODEL // (3 * 256)) * 256

A_Q = ATT_HEADS * ATT_HEAD_DIM
A_KV = ATT_KV_HEADS * ATT_HEAD_DIM
I_Q = IDX_HEADS * IDX_DIM
I_K = IDX_DIM
I_W = IDX_HEADS
B_QK = GDN_HEADS * GDN_DK
B_V = GDN_HEADS * GDN_DV
B_QKV = 2 * B_QK + B_V
B_A = GDN_HEADS
B_B = GDN_HEADS
G_A = A_Q
G_B = B_V
IN_SPLITS = (A_Q, A_KV, A_KV, I_Q, I_K, I_W, B_QKV, B_A, B_B, G_A, G_B)
IN_COLS = A_Q + 2 * A_KV + I_Q + I_K + I_W + B_QKV + B_A + B_B + G_A + G_B

kernel_name = "hybrid_dsa_gdn_parallel_block"


def _split_points(sizes):
    return [int(v) for v in np.cumsum(sizes)[:-1]]


def _rms_norm(x, g):
    xf = x.astype(jnp.float32)
    y = xf * lax.rsqrt(jnp.mean(xf * xf, axis=-1, keepdims=True) + EPS)
    return (y * g.astype(jnp.float32)).astype(x.dtype)


def _l2norm(x):
    return x * lax.rsqrt(jnp.sum(x * x, axis=-1, keepdims=True) + EPS)


def _rope(x, positions):
    d = x.shape[-1]
    half = d // 2
    inv_freq = ROPE_THETA ** (-jnp.arange(half, dtype=jnp.float32) * 2.0 / d)
    ang = positions.astype(jnp.float32)[:, :, None] * inv_freq
    cos = jnp.cos(ang)[:, :, None, :]
    sin = jnp.sin(ang)[:, :, None, :]
    xf = x.astype(jnp.float32)
    x1, x2 = xf[..., :half], xf[..., half:]
    return jnp.concatenate([x1 * cos - x2 * sin, x2 * cos + x1 * sin], axis=-1).astype(x.dtype)


def _dsa_attention(q, k, v, q_idx, k_idx, w_idx, topk):
    B, S, H, Dh = q.shape
    G = ATT_KV_HEADS
    R = H // G
    n_blk = S // Q_BLOCK

    def to_blocks(a):
        return jnp.swapaxes(a.reshape((B, n_blk, Q_BLOCK) + a.shape[2:]), 0, 1)

    starts = jnp.arange(n_blk, dtype=jnp.int32) * Q_BLOCK
    key_pos = jnp.arange(S, dtype=jnp.int32)
    k_idx_f = k_idx.astype(jnp.float32)
    scale = Dh ** -0.5
    idx_scale = IDX_DIM ** -0.5

    def one_block(args):
        qb, qib, wb, t0 = args
        t_pos = t0 + jnp.arange(Q_BLOCK, dtype=jnp.int32)
        logits = jnp.einsum('bthd,bsd->bths', qib.astype(jnp.float32), k_idx_f) * idx_scale
        score = jnp.einsum('bth,bths->bts', wb.astype(jnp.float32), jax.nn.relu(logits))
        causal = key_pos[None, :] <= t_pos[:, None]
        score = jnp.where(causal[None], score, -jnp.inf)
        _, sel = lax.top_k(score, topk)
        valid = sel <= t_pos[None, :, None]
        kg = jax.vmap(lambda a, i: a[i])(k, sel)
        vg = jax.vmap(lambda a, i: a[i])(v, sel)
        qg = qb.reshape(B, Q_BLOCK, G, R, Dh).astype(jnp.float32)
        s = jnp.einsum('btgrd,btngd->btgrn', qg, kg.astype(jnp.float32)) * scale
        s = jnp.where(valid[:, :, None, None, :], s, -jnp.inf)
        p = jax.nn.softmax(s, axis=-1)
        o = jnp.einsum('btgrn,btngd->btgrd', p, vg.astype(jnp.float32))
        return o.reshape(B, Q_BLOCK, H * Dh).astype(q.dtype)

    out = lax.map(one_block, (to_blocks(q), to_blocks(q_idx), to_blocks(w_idx), starts))
    return jnp.swapaxes(out, 0, 1).reshape(B, S, H * Dh)


def _causal_conv_silu(x, w):
    K = w.shape[0]
    S = x.shape[1]
    xp = jnp.pad(x, ((0, 0), (K - 1, 0), (0, 0)))
    y = xp[:, 0:S] * w[0]
    for j in range(1, K):
        y = y + xp[:, j:j + S] * w[j]
    return jax.nn.silu(y)


def _gated_delta_rule(q, k, v, g, beta):
    B, S, H, Dk = q.shape
    Dv = v.shape[-1]
    C = CHUNK
    N = S // C

    def chunks(a):
        a = a.reshape((B, N, C, H) + a.shape[3:])
        return jnp.moveaxis(a, 3, 1)

    q = chunks(q) * (Dk ** -0.5)
    k = chunks(k)
    v = chunks(v)
    g = chunks(g)
    beta = chunks(beta)
    g_cum = jnp.cumsum(g, axis=-1)
    tril = jnp.tril(jnp.ones((C, C), dtype=bool))
    strict = jnp.tril(jnp.ones((C, C), dtype=bool), -1)
    diff = g_cum[..., :, None] - g_cum[..., None, :]
    decay = jnp.where(tril, jnp.exp(jnp.where(tril, diff, 0.0)), 0.0)
    k_beta = k * beta[..., None]
    v_beta = v * beta[..., None]
    m = jnp.where(strict, jnp.einsum('bhnid,bhnjd->bhnij', k_beta, k) * decay, 0.0)
    a_mat = m + jnp.eye(C, dtype=jnp.float32)
    rhs = jnp.concatenate([v_beta, k_beta * jnp.exp(g_cum)[..., None]], axis=-1)
    sol = lax.linalg.triangular_solve(a_mat, rhs, left_side=True, lower=True, unit_diagonal=True)
    u = sol[..., :Dv]
    w = sol[..., Dv:]
    attn = jnp.einsum('bhnid,bhnjd->bhnij', q, k) * decay
    q_dec = q * jnp.exp(g_cum)[..., None]
    k_dec = k * jnp.exp(g_cum[..., -1:] - g_cum)[..., None]
    g_last = jnp.exp(g_cum[..., -1])

    def step(state, xs):
        u_c, w_c, attn_c, qd_c, kd_c, gl_c = xs
        v_new = u_c - jnp.einsum('bhcd,bhde->bhce', w_c, state)
        o = jnp.einsum('bhcd,bhde->bhce', qd_c, state) + jnp.einsum('bhij,bhje->bhie', attn_c, v_new)
        state = state * gl_c[..., None, None] + jnp.einsum('bhcd,bhce->bhde', kd_c, v_new)
        return state, o

    xs = (jnp.moveaxis(u, 2, 0), jnp.moveaxis(w, 2, 0), jnp.moveaxis(attn, 2, 0),
          jnp.moveaxis(q_dec, 2, 0), jnp.moveaxis(k_dec, 2, 0), jnp.moveaxis(g_last, 2, 0))
    state0 = jnp.zeros((B, H, Dk, Dv), dtype=jnp.float32)
    _, o = lax.scan(step, state0, xs)
    return jnp.transpose(o, (1, 0, 3, 2, 4)).reshape(B, S, H, Dv)


def _hybrid_mixer(h, positions, w_in, conv_w, a_log, dt_bias, gdn_norm, w_out, topk):
    B, S, _ = h.shape
    proj = h @ w_in
    (a_q, a_k, a_v, i_q, i_k, i_w, b_qkv, b_a, b_b, g_a, g_b) = jnp.split(
        proj, _split_points(IN_SPLITS), axis=-1)

    q = _rope(a_q.reshape(B, S, ATT_HEADS, ATT_HEAD_DIM), positions)
    k = _rope(a_k.reshape(B, S, ATT_KV_HEADS, ATT_HEAD_DIM), positions)
    v = a_v.reshape(B, S, ATT_KV_HEADS, ATT_HEAD_DIM)
    qi = _rope(i_q.reshape(B, S, IDX_HEADS, IDX_DIM), positions)
    ki = _rope(i_k.reshape(B, S, 1, IDX_DIM), positions)[:, :, 0]
    wi = i_w * (IDX_HEADS ** -0.5)
    y_a = _dsa_attention(q, k, v, qi, ki, wi, topk)

    qkv = _causal_conv_silu(b_qkv, conv_w)
    bq, bk, bv = jnp.split(qkv, [B_QK, 2 * B_QK], axis=-1)
    bq = _l2norm(bq.astype(jnp.float32).reshape(B, S, GDN_HEADS, GDN_DK))
    bk = _l2norm(bk.astype(jnp.float32).reshape(B, S, GDN_HEADS, GDN_DK))
    bv = bv.astype(jnp.float32).reshape(B, S, GDN_HEADS, GDN_DV)
    g = -jnp.exp(a_log.astype(jnp.float32)) * jax.nn.softplus(
        b_a.astype(jnp.float32) + dt_bias.astype(jnp.float32))
    beta = jax.nn.sigmoid(b_b.astype(jnp.float32))
    o_b = _gated_delta_rule(bq, bk, bv, g, beta)
    y_b = _rms_norm(o_b, gdn_norm).reshape(B, S, B_V).astype(h.dtype)

    y = jax.nn.sigmoid(g_a) * y_a + jax.nn.sigmoid(g_b) * y_b
    return y @ w_out


def _memory_cross_attention(h, mem_n, w_xq, w_xkv, w_xo):
    B, S, _ = h.shape
    M = mem_n.shape[1]
    q = (h @ w_xq).reshape(B, S, XATT_HEADS, XATT_HEAD_DIM)
    kv = mem_n @ w_xkv
    k, v = jnp.split(kv, 2, axis=-1)
    k = k.reshape(B, M, XATT_HEADS, XATT_HEAD_DIM)
    v = v.reshape(B, M, XATT_HEADS, XATT_HEAD_DIM)
    s = jnp.einsum('bshd,bmhd->bhsm', q.astype(jnp.float32), k.astype(jnp.float32)) * (XATT_HEAD_DIM ** -0.5)
    p = jax.nn.softmax(s, axis=-1)
    o = jnp.einsum('bhsm,bmhd->bshd', p, v.astype(jnp.float32)).astype(h.dtype)
    return o.reshape(B, S, D_MODEL) @ w_xo


def _swiglu(h, w_gu, w_down):
    gate, up = jnp.split(h @ w_gu, 2, axis=-1)
    return (jax.nn.silu(gate) * up) @ w_down


def setup_inputs(seed: int = 0) -> dict:
    key = jax.random.key(seed)
    ks = jax.random.split(key, 24)
    f32 = jnp.float32

    def dense(k, shape, fan_in):
        return jax.random.normal(k, shape, f32) * (fan_in ** -0.5)

    def gain(k):
        return 1.0 + 0.02 * jax.random.normal(k, (DEPTH, D_MODEL), f32)

    x = jax.random.normal(ks[0], (BATCH, SEQ, D_MODEL), f32)
    mem = jax.random.normal(ks[1], (BATCH, N_MEM, D_MODEL), f32)
    offsets = jax.random.randint(ks[2], (BATCH, 1), 0, 1024, dtype=jnp.int32)
    positions = offsets + jnp.arange(SEQ, dtype=jnp.int32)[None, :]
    dt = jnp.exp(jax.random.uniform(ks[6], (DEPTH, GDN_HEADS), f32,
                                    jnp.log(0.001), jnp.log(0.1)))
    return {
        "x": x,
        "mem": mem,
        "positions": positions,
        "norm_mix_pre": gain(ks[3]),
        "w_in": dense(ks[4], (DEPTH, D_MODEL, IN_COLS), D_MODEL),
        "conv_w": 0.5 * jax.random.normal(ks[5], (DEPTH, CONV_K, B_QKV), f32),
        "a_log": jnp.log(jax.random.uniform(ks[7], (DEPTH, GDN_HEADS), f32, 1.0, 16.0)),
        "dt_bias": dt + jnp.log(-jnp.expm1(-dt)),
        "gdn_norm": 1.0 + 0.02 * jax.random.normal(ks[8], (DEPTH, GDN_DV), f32),
        "w_out": dense(ks[9], (DEPTH, A_Q, D_MODEL), A_Q),
        "norm_mix_post": gain(ks[10]),
        "norm_x_pre": gain(ks[11]),
        "norm_mem": gain(ks[12]),
        "w_xq": dense(ks[13], (DEPTH, D_MODEL, D_MODEL), D_MODEL),
        "w_xkv": dense(ks[14], (DEPTH, D_MODEL, 2 * D_MODEL), D_MODEL),
        "w_xo": dense(ks[15], (DEPTH, D_MODEL, D_MODEL), D_MODEL),
        "norm_x_post": gain(ks[16]),
        "norm_ffn_pre": gain(ks[17]),
        "w_gu": dense(ks[18], (DEPTH, D_MODEL, 2 * FF_DIM), D_MODEL),
        "w_down": dense(ks[19], (DEPTH, FF_DIM, D_MODEL), FF_DIM),
        "norm_ffn_post": gain(ks[20]),
    }


def reference(x, mem, positions, norm_mix_pre, w_in, conv_w, a_log, dt_bias, gdn_norm, w_out,
              norm_mix_post, norm_x_pre, norm_mem, w_xq, w_xkv, w_xo, norm_x_post,
              norm_ffn_pre, w_gu, w_down, norm_ffn_post):
    S = x.shape[1]
    topk = min(TOPK_MAX, S // 4)
    for l in range(DEPTH):
        h = _rms_norm(x, norm_mix_pre[l])
        y = _hybrid_mixer(h, positions, w_in[l], conv_w[l], a_log[l], dt_bias[l], gdn_norm[l],
                          w_out[l], topk)
        x = x + _rms_norm(y, norm_mix_post[l])
        h = _rms_norm(x, norm_x_pre[l])
        mem_n = _rms_norm(mem, norm_mem[l])
        y = _memory_cross_attention(h, mem_n, w_xq[l], w_xkv[l], w_xo[l])
        x = x + _rms_norm(y, norm_x_post[l])
        h = _rms_norm(x, norm_ffn_pre[l])
        y = _swiglu(h, w_gu[l], w_down[l])
        x = x + _rms_norm(y, norm_ffn_post[l])
    return x
```

```cpp
#include <hip/hip_runtime.h>
#include <stdint.h>
#include <stdio.h>
#include <math.h>
#include <string.h>

#define LAS __attribute__((address_space(3)))
typedef unsigned short bf16_t;
typedef short bf16x8 __attribute__((ext_vector_type(8)));
typedef float f32x4 __attribute__((ext_vector_type(4)));
typedef float f32x2 __attribute__((ext_vector_type(2)));
typedef unsigned u32x4 __attribute__((ext_vector_type(4)));
typedef unsigned u32x2 __attribute__((ext_vector_type(2)));

constexpr int D_MODEL = 1024, BATCH = 2, SEQ = 16384, DEPTH = 2, MTOK = BATCH * SEQ;
constexpr int N_MEM = 256, FF = 2816, IN_COLS = 6996, TOPK = 256;
constexpr int OFF_AQ = 0, OFF_AK = 1024, OFF_AV = 1280, OFF_IQ = 1536, OFF_IK = 1792, OFF_IW = 1856, OFF_BQKV = 1860, OFF_BA = 4932, OFF_BB = 4940, OFF_GA = 4948, OFF_GB = 5972;
constexpr float EPS = 1e-6f;
constexpr int NTHREADS = 512, NWAVES = 8;
constexpr int LDS_BYTES = 151552;
constexpr int LDS_SCRATCH = 131072;

typedef __bf16 bf16x2_t __attribute__((ext_vector_type(2)));
__device__ __forceinline__ unsigned cvt_pk_bf16(float lo, float hi) { const f32x2 v = {lo, hi}; const bf16x2_t r = __builtin_convertvector(v, bf16x2_t); return __builtin_bit_cast(unsigned, r); }
__device__ __forceinline__ bf16_t f2bf(float x) { return (bf16_t)(cvt_pk_bf16(x, 0.f) & 0xffffu); }
__device__ __forceinline__ float bf2f(bf16_t x) { return __uint_as_float(((unsigned)x) << 16); }
__device__ __forceinline__ float bflo(unsigned w) { return __uint_as_float(w << 16); }
__device__ __forceinline__ float bfhi(unsigned w) { return __uint_as_float(w & 0xffff0000u); }
__device__ __forceinline__ float relu_(float x) { return __int_as_float(max(__float_as_int(x), 0)); }
__device__ __forceinline__ float sigmoidf_(float x) { return __builtin_amdgcn_rcpf(1.0f + __expf(-x)); }
__device__ __forceinline__ int tid_opaque() { int t = threadIdx.x; asm volatile("" : "+v"(t)); return t; }
#define WS_DPP(v, ctrl, rowmask) __int_as_float(__builtin_amdgcn_update_dpp(0, __float_as_int(v), (ctrl), (rowmask), 0xf, false))
__device__ __forceinline__ float wave_sum(float v) {
    v += WS_DPP(v, 0x111, 0xf); v += WS_DPP(v, 0x112, 0xf); v += WS_DPP(v, 0x114, 0xf); v += WS_DPP(v, 0x118, 0xf);
    v += WS_DPP(v, 0x142, 0xa); v += WS_DPP(v, 0x143, 0xc);
    return __int_as_float(__builtin_amdgcn_readlane(__float_as_int(v), 63));
}
__device__ __forceinline__ float wave_max(float v) {
#pragma unroll
    for (int o = 32; o > 0; o >>= 1) v = fmaxf(v, __shfl_xor(v, o));
    return v;
}

#define XB_TMO      128
#define XB_XCNT(j)  (256  + 64 * (j))
#define XB_XSUB(j)  (1280 + 64 * (j))
#define XB_XGEN(j)  (2304 + 64 * (j))
#define XB_TOP      3328
#define XB_TOPGEN   3392
#define XCD_BAR_WORDS 3456
#define XB_SPIN_CAP (1u << 25)

__device__ __forceinline__ unsigned xb_ld(unsigned* p)              { return __hip_atomic_load(p, __ATOMIC_RELAXED, __HIP_MEMORY_SCOPE_AGENT); }
__device__ __forceinline__ unsigned xb_add(unsigned* p, unsigned v) { return __hip_atomic_fetch_add(p, v, __ATOMIC_RELAXED, __HIP_MEMORY_SCOPE_AGENT); }
__device__ __forceinline__ unsigned xb_xcc_id() { return (unsigned)__builtin_amdgcn_s_getreg((3 << 11) | 20) & 0xFu; }
#define XB_SPIN(cond, bar) do { unsigned _sp = 0; while (cond) { __builtin_amdgcn_s_sleep(1); \
    if ((++_sp & 255u) == 0u) { if (xb_ld(&(bar)[XB_TMO])) break; if (_sp > XB_SPIN_CAP) { atomicAdd(&(bar)[XB_TMO], 1u); break; } } } } while (0)

struct XcdBarrier { unsigned* bar; unsigned x; volatile LAS unsigned* st; };

__device__ __forceinline__ XcdBarrier xcd_barrier_post(unsigned* bar, volatile LAS unsigned* st) {
    XcdBarrier b; b.bar = bar; b.x = xb_xcc_id(); b.st = st;
    if (threadIdx.x == 0) (void)xb_add(&bar[XB_XCNT(b.x)], 1u);
    return b;
}
__device__ __forceinline__ void xcd_barrier_complete(unsigned* bar, unsigned x, unsigned& nloc, unsigned& nx) {
    const unsigned G = gridDim.x * gridDim.y * gridDim.z;
    unsigned sum, cnt, mine, sp = 0u;
    for (;;) {
        sum = 0u; cnt = 0u; mine = 0u;
#pragma unroll
        for (unsigned j = 0; j < 16; ++j) { const unsigned c = xb_ld(&bar[XB_XCNT(j)]); sum += c; cnt += (c > 0u) ? 1u : 0u; mine = (j == x) ? c : mine; }
        if (sum == G) break;
        __builtin_amdgcn_s_sleep(1);
        if ((++sp & 255u) == 0u) { if (xb_ld(&bar[XB_TMO])) break; if (sp > XB_SPIN_CAP) { atomicAdd(&bar[XB_TMO], 1u); break; } }
    }
    nloc = mine > 0u ? mine : 1u; nx = cnt > 0u ? cnt : 1u;
}
__device__ __forceinline__ void xcd_barrier(const XcdBarrier& b) {
    asm volatile("s_waitcnt vmcnt(0)" ::: "memory");
    __syncthreads();
    if (threadIdx.x == 0) {
        unsigned* bar = b.bar;
        __builtin_amdgcn_s_waitcnt(0);
        unsigned nloc = b.st[0], nx = b.st[1];
        if (nloc == 0u) { xcd_barrier_complete(bar, b.x, nloc, nx); b.st[0] = nloc; b.st[1] = nx; }
        const unsigned old = xb_add(&bar[XB_XSUB(b.x)], 1u);
        const unsigned gen = old / nloc;
        if (old + 1u == (gen + 1u) * nloc) {
            __builtin_amdgcn_fence(__ATOMIC_RELEASE, "agent");
            asm volatile("s_waitcnt vmcnt(0)" ::: "memory");
            const unsigned og = xb_add(&bar[XB_TOP], 1u);
            const unsigned tg = og / nx;
            if (og + 1u == (tg + 1u) * nx) xb_add(&bar[XB_TOPGEN], 1u);
            else XB_SPIN(xb_ld(&bar[XB_TOPGEN]) == tg, bar);
            __builtin_amdgcn_fence(__ATOMIC_ACQUIRE, "agent");
            xb_add(&bar[XB_XGEN(b.x)], 1u);
            asm volatile("s_waitcnt vmcnt(0)" ::: "memory");
        } else {
            XB_SPIN(xb_ld(&bar[XB_XGEN(b.x)]) == gen, bar);
            __builtin_amdgcn_fence(__ATOMIC_ACQUIRE, "agent");
            asm volatile("s_waitcnt vmcnt(0)" ::: "memory");
        }
    }
    __syncthreads();
}

namespace pg8 {
constexpr int BM = 256, BK = 64, HALF = 128, HTB = HALF * BK * 2, STAGE_BYTES = 8 * HTB, NXCD = 8, WGM = 8;
__host__ __device__ __forceinline__ int lds_byte(int r, int c) { const int st = (r >> 4) * 2 + (c >> 5), rr = r & 15, cc = c & 31, ob = rr * 64 + cc * 2; return st * 1024 + (ob ^ (((ob >> 9) & 1) << 5)); }
__host__ __device__ __forceinline__ void stage_rc(int b, int& R, int& C) { const int st = b / 1024, sb = b % 1024, swz = sb ^ (((sb >> 9) & 1) << 5); R = (st >> 1) * 16 + swz / 64; C = (st & 1) * 32 + (swz % 64) / 2; }
struct Unit { int pm, pn; };
struct Gemm {
    const bf16_t* A; const bf16_t* Bt; int lda, ldb, K, M, N; long a_pn, b_pn; int bat_div; long b_bat;
    __device__ __forceinline__ const char* abase(const Unit& u) const { return (const char*)(A + (long)u.pm * BM * lda + (long)u.pn * a_pn); }
    __device__ __forceinline__ const char* bbase(const Unit& u) const { return (const char*)(Bt + (long)u.pn * b_pn + (bat_div ? (long)(u.pm / bat_div) * b_bat : 0l)); }
};
__host__ __device__ inline Gemm make_gemm(const bf16_t* A, const bf16_t* Bt, int M, int N, int K) { Gemm g; g.A = A; g.Bt = Bt; g.lda = K; g.ldb = K; g.K = K; g.M = M; g.N = N; g.a_pn = 0; g.b_pn = (long)BM * K; g.bat_div = 0; g.b_bat = 0; return g; }

struct StaticOrder {
    int nM, nN, nwg, G, c;
    __host__ __device__ void init(int M, int N, int G_, int c_) { nM = M / BM; nN = N / BM; nwg = nM * nN; G = G_; c = c_; }
    __host__ __device__ bool next(int i, Unit& u) const {
        const long L = (long)i * G + c; if (L >= nwg) return false;
        int wgid = (int)L; { const int q = nwg / NXCD, r = nwg % NXCD, xcd = wgid % NXCD, off = wgid / NXCD; wgid = (xcd < r ? xcd * (q + 1) : r * (q + 1) + (xcd - r) * q) + off; }
        const int nig = WGM * nN, gid = wgid / nig, fm = gid * WGM, gsz = (nM - fm) < WGM ? (nM - fm) : WGM;
        u.pm = fm + ((wgid % nig) % gsz); u.pn = (wgid % nig) / gsz; return true;
    }
};

template <class Epi>
__device__ __forceinline__ void gemm_phase(LAS unsigned char* lds, const Gemm g, const StaticOrder& S, const Epi& E) {
    const int tid = tid_opaque(), wid = __builtin_amdgcn_readfirstlane(tid >> 6), lane = tid & 63, wr = wid >> 2, wc = wid & 3, fr = lane & 15, fq = lane >> 4;
    const int K = g.K, nt = K / BK;
    unsigned voffA[2], voffB[2];
#pragma unroll
    for (int i = 0; i < 2; ++i) { int R, C; stage_rc(tid * 16 + i * 8192, R, C); voffA[i] = (unsigned)(R * g.lda + C) * 2u; voffB[i] = (unsigned)(R * g.ldb + C) * 2u; }
    const size_t kstep = (size_t)(BK * 2);
    const size_t hstepA = (size_t)HALF * g.lda * 2, hstepB = (size_t)HALF * g.ldb * 2;
    const unsigned ldsw = (unsigned)wid * 1024u;
    const int aoff = lds_byte(wr * 64 + fr, fq * 8), boff = lds_byte(wc * 32 + fr, fq * 8);
#define PG8_SA(b, h) (((b) * 2 + (h)) * HTB)
#define PG8_SB(b, h) ((4 + (b) * 2 + (h)) * HTB)
#define PG8_STAGE(bufoff, gbase, voff) do { _Pragma("unroll") for (int _i = 0; _i < 2; ++_i) \
        __builtin_amdgcn_global_load_lds((const unsigned*)((const char*)(gbase) + (voff)[_i]), (LAS unsigned*)(lds + (bufoff) + ldsw + _i * 8192), 16, 0, 0); } while (0)
#define PG8_LDA(dst, b, h) do { _Pragma("unroll") for (int m = 0; m < 4; ++m) _Pragma("unroll") for (int k = 0; k < 2; ++k) dst[m][k] = *(const LAS bf16x8*)(lds + PG8_SA(b, h) + aoff + m * 2048 + k * 1024); } while (0)
#define PG8_LDB(dst, b, h) do { _Pragma("unroll") for (int n = 0; n < 2; ++n) _Pragma("unroll") for (int k = 0; k < 2; ++k) dst[n][k] = *(const LAS bf16x8*)(lds + PG8_SB(b, h) + boff + n * 2048 + k * 1024); } while (0)
#define PG8_MMA(ai, bj, At, Bt) do { __builtin_amdgcn_s_setprio(1); _Pragma("unroll") for (int m = 0; m < 4; ++m) _Pragma("unroll") for (int n = 0; n < 2; ++n) _Pragma("unroll") for (int k = 0; k < 2; ++k) \
        acc[ai][bj][m][n] = __builtin_amdgcn_mfma_f32_16x16x32_bf16(Bt[n][k], At[m][k], acc[ai][bj][m][n], 0, 0, 0); __builtin_amdgcn_s_setprio(0); } while (0)
#define PG8_WAIT_V(n) asm volatile("s_waitcnt vmcnt(" #n ")" ::: "memory")
#define PG8_WAIT_L(n) asm volatile("s_waitcnt lgkmcnt(" #n ")" ::: "memory")
#define PG8_BAR __builtin_amdgcn_s_barrier()
#define PG8_SCHED __builtin_amdgcn_sched_barrier(0)
    Unit cur, nxt; int ui = 0;
    if (!S.next(0, cur)) return;
    f32x4 acc[2][2][4][2];
#pragma unroll
    for (int a = 0; a < 2; ++a)
#pragma unroll
        for (int b = 0; b < 2; ++b)
#pragma unroll
            for (int m = 0; m < 4; ++m)
#pragma unroll
                for (int n = 0; n < 2; ++n) acc[a][b][m][n] = (f32x4){0.f, 0.f, 0.f, 0.f};
    bf16x8 At[4][2], B0[2][2], B1[2][2];
    const char* cA = g.abase(cur); const char* cB = g.bbase(cur);
    PG8_STAGE(PG8_SB(0, 0), cB, voffB); PG8_STAGE(PG8_SB(0, 1), cB + hstepB, voffB); PG8_STAGE(PG8_SA(0, 0), cA, voffA); PG8_STAGE(PG8_SA(0, 1), cA + hstepA, voffA);
    if (wr == 1) PG8_BAR;
    PG8_WAIT_V(2); PG8_BAR;
    PG8_STAGE(PG8_SB(1, 0), cB + kstep, voffB); PG8_STAGE(PG8_SA(1, 0), cA + kstep, voffA); PG8_STAGE(PG8_SB(1, 1), cB + hstepB + kstep, voffB);
    PG8_WAIT_V(6); PG8_BAR;
    for (;;) {
        const bool has_next = S.next(ui + 1, nxt);
        const char* nA = has_next ? g.abase(nxt) : cA; const char* nB = has_next ? g.bbase(nxt) : cB;
        for (int t = 0; t < nt; t += 2) {
            const bool last = (t == nt - 2);
            const char* a1 = cA + (size_t)(t + 1) * kstep;
            const char* a2 = last ? nA : cA + (size_t)(t + 2) * kstep; const char* b2 = last ? nB : cB + (size_t)(t + 2) * kstep;
            const char* a3 = a2 + kstep; const char* b3 = b2 + kstep;
            PG8_LDB(B0, 0, 0); PG8_LDB(B1, 0, 1); PG8_SCHED; PG8_LDA(At, 0, 0); PG8_STAGE(PG8_SA(1, 1), a1 + hstepA, voffA);
            PG8_WAIT_V(8); PG8_WAIT_L(0); PG8_BAR; PG8_MMA(0, 0, At, B0); PG8_MMA(0, 1, At, B1); PG8_BAR; PG8_SCHED;
            PG8_LDA(At, 0, 1); PG8_STAGE(PG8_SB(0, 0), b2, voffB); PG8_STAGE(PG8_SB(0, 1), b2 + hstepB, voffB); PG8_STAGE(PG8_SA(0, 0), a2, voffA);
            PG8_WAIT_V(8); PG8_WAIT_L(0); PG8_BAR; PG8_MMA(1, 0, At, B0); PG8_MMA(1, 1, At, B1); PG8_BAR; PG8_SCHED;
            PG8_LDB(B0, 1, 0); PG8_LDB(B1, 1, 1); PG8_SCHED; PG8_LDA(At, 1, 0); PG8_STAGE(PG8_SA(0, 1), a2 + hstepA, voffA);
            PG8_WAIT_V(8); PG8_WAIT_L(0); PG8_BAR; PG8_MMA(0, 0, At, B0); PG8_MMA(0, 1, At, B1); PG8_BAR; PG8_SCHED;
            PG8_LDA(At, 1, 1); PG8_STAGE(PG8_SB(1, 0), b3, voffB); PG8_STAGE(PG8_SB(1, 1), b3 + hstepB, voffB); PG8_STAGE(PG8_SA(1, 0), a3, voffA);
            PG8_WAIT_V(8); PG8_WAIT_L(0); PG8_BAR; PG8_MMA(1, 0, At, B0); PG8_MMA(1, 1, At, B1); PG8_BAR; PG8_SCHED;
        }
        if (wr == 0) PG8_BAR;
        E(acc, cur, wr, wc, fr, fq);
        if (!has_next) break;
#pragma unroll
        for (int a = 0; a < 2; ++a)
#pragma unroll
            for (int b = 0; b < 2; ++b)
#pragma unroll
                for (int m = 0; m < 4; ++m)
#pragma unroll
                    for (int n = 0; n < 2; ++n) acc[a][b][m][n] = (f32x4){0.f, 0.f, 0.f, 0.f};
        cur = nxt; cA = nA; cB = nB; ++ui;
        if (wr == 1) PG8_BAR;
    }
    PG8_WAIT_V(0);
    PG8_BAR;
#undef PG8_SA
#undef PG8_SB
#undef PG8_STAGE
#undef PG8_LDA
#undef PG8_LDB
#undef PG8_MMA
#undef PG8_WAIT_V
#undef PG8_WAIT_L
#undef PG8_BAR
#undef PG8_SCHED
}
}
using pg8::Unit; using pg8::Gemm; using pg8::StaticOrder;

struct Params {
    const float* x; const float* mem; const int* positions;
    const float* norm_mix_pre; const float* w_in; const float* conv_w; const float* a_log; const float* dt_bias; const float* gdn_norm; const float* w_out;
    const float* norm_mix_post; const float* norm_x_pre; const float* norm_mem; const float* w_xq; const float* w_xkv; const float* w_xo; const float* norm_x_post;
    const float* norm_ffn_pre; const float* w_gu; const float* w_down; const float* norm_ffn_post;
    float* out;
    unsigned* bar;
    bf16_t* wt;
    float* rope_cos; float* rope_sin;
    bf16_t* memn;
    bf16_t* xk;
    bf16_t* xvt;
    bf16_t* xn;
    bf16_t* qb;
    bf16_t* kb; bf16_t* vb; bf16_t* qib; bf16_t* kib;
    float* wi; float* gg; float* beta;
    bf16_t* raw;
    bf16_t* sel;
    bf16_t* halo;
    bf16_t* ta;
    float* npart;
};
typedef const __attribute__((address_space(4))) Params* KP;
constexpr long WT_IN = 0, WT_GATE = WT_IN + 5120l * 1024, WT_OUT = WT_GATE + 2048l * 1024, WT_XQ = WT_OUT + 1024l * 1024, WT_XKV = WT_XQ + 1024l * 1024,
               WT_XO = WT_XKV + 2048l * 1024, WT_GU = WT_XO + 1024l * 1024, WT_DOWN = WT_GU + 5632l * 1024, WT_LAYER = WT_DOWN + 1024l * 2816;

__device__ __forceinline__ int map_plain(int c) { return (c & ~31) + 8 * ((c >> 2) & 3) + 4 * ((c >> 4) & 1) + (c & 3); }
__device__ __forceinline__ int map_pair(int c, int second_off) {
    const int blk = c >> 7, wc = (c >> 5) & 3, n = (c >> 4) & 1, fq = (c >> 2) & 3, i = c & 3; const int cc = 64 * blk + 16 * wc + 4 * fq + i; return n ? second_off + cc : cc; }
__device__ __forceinline__ int map_in(int c) {
    const int pn = c >> 8, bj = (c >> 7) & 1, wc = (c >> 5) & 3, n = (c >> 4) & 1, fq = (c >> 2) & 3, i = c & 3;
    if (pn < 5) { const int head = (pn < 4) ? 2 * pn + bj : bj; const int d = n * 64 + 16 * wc + 4 * fq + i; return (pn < 4 ? OFF_AQ : OFF_AK) + head * 128 + d; }
    if (pn == 5) return OFF_AV + map_plain(c & 255);
    if (pn == 6) { const int head = 2 * bj + (wc >> 1); const int d = n * 32 + 16 * (wc & 1) + 4 * fq + i; return OFF_IQ + head * 64 + d; }
    if (pn == 7) {
        if (bj == 1 || wc == 3) return -1;
        if (wc < 2) return OFF_IK + n * 32 + 16 * wc + 4 * fq + i;
        const int s = 16 * n + 4 * fq + i;
        if (s < 4) return OFF_IW + s; if (s < 12) return OFF_BA + (s - 4); if (s < 20) return OFF_BB + (s - 12); return -1;
    }
    return OFF_BQKV + map_plain(c - 2048);
}
struct WtTile { const float* src; bf16_t* dst; int ld, K, n0, k0, kind, soff; };
__device__ __forceinline__ int wt_col(const WtTile& w, int c) { return w.kind == 0 ? map_plain(c) : (w.kind == 1 ? map_pair(c, w.soff) : map_in(c)); }
__device__ __forceinline__ void load_row_f32(const float* p, float (&v)[16]) {
#pragma unroll
    for (int j = 0; j < 4; ++j) { const f32x4 t = *(const f32x4*)(p + 4 * j); v[4 * j] = t[0]; v[4 * j + 1] = t[1]; v[4 * j + 2] = t[2]; v[4 * j + 3] = t[3]; }
}
__device__ __forceinline__ void load_row_bf16(const bf16_t* p, float (&v)[16]) {
#pragma unroll
    for (int j = 0; j < 2; ++j) { const u32x4 t = *(const u32x4*)(p + 8 * j);
        v[8 * j] = bflo(t.x); v[8 * j + 1] = bfhi(t.x); v[8 * j + 2] = bflo(t.y); v[8 * j + 3] = bfhi(t.y); v[8 * j + 4] = bflo(t.z); v[8 * j + 5] = bfhi(t.z); v[8 * j + 6] = bflo(t.w); v[8 * j + 7] = bfhi(t.w); }
}
__device__ __forceinline__ void store_row_bf16(bf16_t* p, const float (&v)[16]) {
#pragma unroll
    for (int j = 0; j < 2; ++j) { u32x4 w; w.x = cvt_pk_bf16(v[8 * j], v[8 * j + 1]); w.y = cvt_pk_bf16(v[8 * j + 2], v[8 * j + 3]); w.z = cvt_pk_bf16(v[8 * j + 4], v[8 * j + 5]); w.w = cvt_pk_bf16(v[8 * j + 6], v[8 * j + 7]);
        *(u32x4*)(p + 8 * j) = w; }
}
__device__ __forceinline__ void store_row_f32(float* p, const float (&v)[16]) {
#pragma unroll
    for (int j = 0; j < 4; ++j) *(f32x4*)(p + 4 * j) = (f32x4){v[4 * j], v[4 * j + 1], v[4 * j + 2], v[4 * j + 3]};
}
__device__ __forceinline__ void phase_norm_rows(const float* x, const float* g, bf16_t* xn, int nrows) {
    const int tid = tid_opaque(); const int lane = tid & 63, gw = blockIdx.x * NWAVES + (tid >> 6), nw = gridDim.x * NWAVES;
    float gv[16]; load_row_f32(g + lane * 16, gv);
    for (int r = gw; r < nrows; r += nw) {
        float v[16]; load_row_f32(x + (size_t)r * 1024 + lane * 16, v);
        float s = 0.f;
#pragma unroll
        for (int j = 0; j < 16; ++j) s += v[j] * v[j];
        s = wave_sum(s); const float rs = rsqrtf(s * (1.0f / 1024.f) + EPS);
#pragma unroll
        for (int j = 0; j < 16; ++j) v[j] = v[j] * rs * gv[j];
        store_row_bf16(xn + (size_t)r * 1024 + lane * 16, v);
    }
}
__device__ __forceinline__ void phase_prologue(KP p, LAS unsigned char* lds) {
    constexpr int T_IN = (5120 / 64) * 16, T_GATE = (2048 / 64) * 16, T_SQ = 16 * 16, T_XKV = 32 * 16, T_GU = (5632 / 64) * 16, T_DOWN = 16 * 44;
    constexpr int T_LAYER = T_IN + T_GATE + 3 * T_SQ + T_XKV + T_GU + T_DOWN;
    auto decode = [&](int t) -> WtTile {
        const int l = t / T_LAYER; int r = t % T_LAYER; bf16_t* wl = p->wt + (size_t)l * WT_LAYER; WtTile w;
        if (r < T_IN) { w = WtTile{p->w_in + (size_t)l * 1024 * IN_COLS, wl + WT_IN, IN_COLS, 1024, (r >> 4) * 64, (r & 15) * 64, 2, 0}; return w; } r -= T_IN;
        if (r < T_GATE) { w = WtTile{p->w_in + (size_t)l * 1024 * IN_COLS + OFF_GA, wl + WT_GATE, IN_COLS, 1024, (r >> 4) * 64, (r & 15) * 64, 1, 1024}; return w; } r -= T_GATE;
        if (r < T_SQ) { w = WtTile{p->w_out + (size_t)l * 1024 * 1024, wl + WT_OUT, 1024, 1024, (r >> 4) * 64, (r & 15) * 64, 0, 0}; return w; } r -= T_SQ;
        if (r < T_SQ) { w = WtTile{p->w_xq + (size_t)l * 1024 * 1024, wl + WT_XQ, 1024, 1024, (r >> 4) * 64, (r & 15) * 64, 0, 0}; return w; } r -= T_SQ;
        if (r < T_XKV) { w = WtTile{p->w_xkv + (size_t)l * 1024 * 2048, wl + WT_XKV, 2048, 1024, (r >> 4) * 64, (r & 15) * 64, 0, 0}; return w; } r -= T_XKV;
        if (r < T_SQ) { w = WtTile{p->w_xo + (size_t)l * 1024 * 1024, wl + WT_XO, 1024, 1024, (r >> 4) * 64, (r & 15) * 64, 0, 0}; return w; } r -= T_SQ;
        if (r < T_GU) { w = WtTile{p->w_gu + (size_t)l * 1024 * 5632, wl + WT_GU, 5632, 1024, (r >> 4) * 64, (r & 15) * 64, 1, 2816}; return w; } r -= T_GU;
        w = WtTile{p->w_down + (size_t)l * 2816 * 1024, wl + WT_DOWN, 1024, 2816, (r / 44) * 64, (r % 44) * 64, 0, 0}; return w; };
    { const int tid = tid_opaque(); const int nl = tid & 63, kb = tid >> 6, nl2 = tid >> 3, kk = (tid & 7) * 8;
      for (int t0 = blockIdx.x; t0 < 2 * T_LAYER; t0 += 4 * gridDim.x) {
          float v[4][8];
#pragma unroll
          for (int g = 0; g < 4; ++g) { const int t = t0 + g * gridDim.x;
              if (t < 2 * T_LAYER) { const WtTile w = decode(t); const int col = wt_col(w, w.n0 + nl);
#pragma unroll
                  for (int q = 0; q < 8; ++q) v[g][q] = col >= 0 ? w.src[(size_t)(w.k0 + q * 8 + kb) * w.ld + col] : 0.f; } }
#pragma unroll
          for (int g = 0; g < 4; ++g) { const int t = t0 + g * gridDim.x; LAS float* tile = (LAS float*)lds + g * (64 * 65);
              if (t < 2 * T_LAYER) {
#pragma unroll
                  for (int q = 0; q < 8; ++q) tile[(q * 8 + kb) * 65 + nl] = v[g][q]; } }
          __syncthreads();
#pragma unroll
          for (int g = 0; g < 4; ++g) { const int t = t0 + g * gridDim.x; const LAS float* tile = (const LAS float*)lds + g * (64 * 65);
              if (t < 2 * T_LAYER) { const WtTile w = decode(t); float x[8];
#pragma unroll
                  for (int j = 0; j < 8; ++j) x[j] = tile[(kk + j) * 65 + nl2];
                  u32x4 o; o.x = cvt_pk_bf16(x[0], x[1]); o.y = cvt_pk_bf16(x[2], x[3]); o.z = cvt_pk_bf16(x[4], x[5]); o.w = cvt_pk_bf16(x[6], x[7]);
                  *(u32x4*)(w.dst + (size_t)(w.n0 + nl2) * w.K + w.k0 + kk) = o; } }
          __syncthreads();
      } }
    for (size_t i = (size_t)blockIdx.x * NTHREADS + tid_opaque(); i < (size_t)MTOK * 64; i += (size_t)gridDim.x * NTHREADS) {
        const int m = (int)(i >> 6), j = (int)(i & 63);
        const float inv_freq = exp2f(-(float)j * 0.20762050593046015f);
        const double a = (double)p->positions[m] * (double)inv_freq * 0.15915494309189535;
        const float fr = (float)(a - floor(a));
        p->rope_cos[i] = __builtin_amdgcn_cosf(fr); p->rope_sin[i] = __builtin_amdgcn_sinf(fr);
    }
    phase_norm_rows(p->mem, p->norm_mem, p->memn, BATCH * N_MEM);
    phase_norm_rows(p->mem, p->norm_mem + 1024, p->memn + (size_t)BATCH * N_MEM * 1024, BATCH * N_MEM);
    phase_norm_rows(p->x, p->norm_mix_pre, p->xn, MTOK);
}

struct EpiPlain {
    bf16_t* O; int ldc; float scale;
    __device__ __forceinline__ void operator()(const f32x4 (&acc)[2][2][4][2], const Unit& u, int wr, int wc, int fr, int fq) const {
        const int row0 = u.pm * 256 + wr * 64 + fr, col0 = u.pn * 256 + wc * 32 + 8 * fq;
#pragma unroll
        for (int ai = 0; ai < 2; ++ai)
#pragma unroll
            for (int m = 0; m < 4; ++m) { bf16_t* rowp = O + (size_t)(row0 + ai * 128 + m * 16) * ldc + col0;
#pragma unroll
                for (int bj = 0; bj < 2; ++bj) { const f32x4 v0 = acc[ai][bj][m][0] * scale, v1 = acc[ai][bj][m][1] * scale;
                    u32x4 w; w.x = cvt_pk_bf16(v0[0], v0[1]); w.y = cvt_pk_bf16(v0[2], v0[3]); w.z = cvt_pk_bf16(v1[0], v1[1]); w.w = cvt_pk_bf16(v1[2], v1[3]);
                    *(u32x4*)(rowp + bj * 128) = w; } }
    }
};
struct EpiF32 {
    float* C; int ldc;
    __device__ __forceinline__ void operator()(const f32x4 (&acc)[2][2][4][2], const Unit& u, int wr, int wc, int fr, int fq) const {
        const int row0 = u.pm * 256 + wr * 64 + fr, col0 = u.pn * 256 + wc * 32 + 4 * fq;
#pragma unroll
        for (int ai = 0; ai < 2; ++ai)
#pragma unroll
            for (int m = 0; m < 4; ++m) { float* rowp = C + (size_t)(row0 + ai * 128 + m * 16) * ldc + col0;
#pragma unroll
                for (int bj = 0; bj < 2; ++bj)
#pragma unroll
                    for (int n = 0; n < 2; ++n) *(f32x4*)(rowp + bj * 128 + n * 16) = acc[ai][bj][m][n]; }
    }
};
struct EpiSoftmaxP {
    bf16_t* P; LAS unsigned char* xl;
    __device__ __forceinline__ void operator()(const f32x4 (&acc)[2][2][4][2], const Unit& u, int wr, int wc, int fr, int fq) const {
        LAS float* mxs = (LAS float*)xl; LAS float* sms = mxs + 1024;
        const int rl0 = wr * 64 + fr;
        float rmax[2][4];
#pragma unroll
        for (int ai = 0; ai < 2; ++ai)
#pragma unroll
            for (int m = 0; m < 4; ++m) { float mx = -INFINITY;
#pragma unroll
                for (int bj = 0; bj < 2; ++bj)
#pragma unroll
                    for (int n = 0; n < 2; ++n) { const f32x4 v = acc[ai][bj][m][n]; mx = fmaxf(mx, fmaxf(fmaxf(v[0], v[1]), fmaxf(v[2], v[3]))); }
                mx = fmaxf(mx, __shfl_xor(mx, 16)); mx = fmaxf(mx, __shfl_xor(mx, 32));
                if (fq == 0) mxs[(rl0 + ai * 128 + m * 16) * 4 + wc] = mx; }
        asm volatile("s_waitcnt lgkmcnt(0)" ::: "memory"); __builtin_amdgcn_s_barrier(); asm volatile("" ::: "memory");
        float p[2][4][16];
#pragma unroll
        for (int ai = 0; ai < 2; ++ai)
#pragma unroll
            for (int m = 0; m < 4; ++m) { const f32x4 q = *(const LAS f32x4*)(mxs + (rl0 + ai * 128 + m * 16) * 4); const float mx = fmaxf(fmaxf(q[0], q[1]), fmaxf(q[2], q[3])); rmax[ai][m] = mx; float sm = 0.f;
#pragma unroll
                for (int bj = 0; bj < 2; ++bj)
#pragma unroll
                    for (int n = 0; n < 2; ++n)
#pragma unroll
                        for (int i = 0; i < 4; ++i) { const float e = __expf(acc[ai][bj][m][n][i] - mx); p[ai][m][bj * 8 + n * 4 + i] = e; sm += e; }
                sm += __shfl_xor(sm, 16); sm += __shfl_xor(sm, 32);
                if (fq == 0) sms[(rl0 + ai * 128 + m * 16) * 4 + wc] = sm; }
        asm volatile("s_waitcnt lgkmcnt(0)" ::: "memory"); __builtin_amdgcn_s_barrier(); asm volatile("" ::: "memory");
        const int row0 = u.pm * 256 + wr * 64 + fr, col0 = u.pn * 256 + wc * 32 + 4 * fq;
#pragma unroll
        for (int ai = 0; ai < 2; ++ai)
#pragma unroll
            for (int m = 0; m < 4; ++m) { const f32x4 q = *(const LAS f32x4*)(sms + (rl0 + ai * 128 + m * 16) * 4); const float inv = 1.0f / ((q[0] + q[1]) + (q[2] + q[3]));
                bf16_t* rowp = P + (size_t)(row0 + ai * 128 + m * 16) * 1024 + col0;
#pragma unroll
                for (int bj = 0; bj < 2; ++bj)
#pragma unroll
                    for (int n = 0; n < 2; ++n) { u32x2 w; w.x = cvt_pk_bf16(p[ai][m][bj * 8 + n * 4] * inv, p[ai][m][bj * 8 + n * 4 + 1] * inv); w.y = cvt_pk_bf16(p[ai][m][bj * 8 + n * 4 + 2] * inv, p[ai][m][bj * 8 + n * 4 + 3] * inv);
                        *(u32x2*)(rowp + bj * 128 + n * 16) = w; } }
        (void)rmax;
    }
};
struct EpiNormFused {
    const float* xin; float* xout; bf16_t* xn; const float* gpost; const float* gpre; float* part; unsigned* cnt; LAS unsigned char* xl;
    __device__ __forceinline__ float exchange(const float (&rowss)[2][4], int which, const Unit& u, int wr, int wc, int fr, int fq) const {
        LAS float* ps = (LAS float*)xl; LAS float* rs = ps + 1024;
        const int tid = (wr * 4 + wc) * 64 + fq * 16 + fr;
#pragma unroll
        for (int ai = 0; ai < 2; ++ai)
#pragma unroll
            for (int m = 0; m < 4; ++m) if (fq == 0) ps[(wr * 64 + fr + ai * 128 + m * 16) * 4 + wc] = rowss[ai][m];
        asm volatile("s_waitcnt lgkmcnt(0)" ::: "memory"); __builtin_amdgcn_s_barrier(); asm volatile("" ::: "memory");
        float* pp = part + (size_t)which * MTOK * 4; unsigned* cc = cnt + (which * 128 + u.pm) * 16;
        if (tid < 256) { const f32x4 q = *(const LAS f32x4*)(ps + tid * 4); const float tot = (q[0] + q[1]) + (q[2] + q[3]);
            __hip_atomic_store((unsigned*)(pp + ((size_t)u.pm * 256 + tid) * 4 + u.pn), __float_as_uint(tot), __ATOMIC_RELAXED, __HIP_MEMORY_SCOPE_AGENT); }
        asm volatile("s_waitcnt vmcnt(0)" ::: "memory"); __builtin_amdgcn_s_barrier(); asm volatile("" ::: "memory");
        if (tid == 0) (void)__hip_atomic_fetch_add(cc, 1u, __ATOMIC_RELAXED, __HIP_MEMORY_SCOPE_AGENT);
        if (tid < 64) { unsigned sp = 0; while ((unsigned)__builtin_amdgcn_readfirstlane((int)__hip_atomic_load(cc, __ATOMIC_RELAXED, __HIP_MEMORY_SCOPE_AGENT)) < 4u) { __builtin_amdgcn_s_sleep(2); if (++sp > (1u << 22)) break; } }
        asm volatile("" ::: "memory"); __builtin_amdgcn_s_barrier(); asm volatile("" ::: "memory");
        if (tid < 256) { const unsigned* gp = (const unsigned*)(pp + ((size_t)u.pm * 256 + tid) * 4);
            const float a = __uint_as_float(__hip_atomic_load(gp, __ATOMIC_RELAXED, __HIP_MEMORY_SCOPE_AGENT)), b = __uint_as_float(__hip_atomic_load(gp + 1, __ATOMIC_RELAXED, __HIP_MEMORY_SCOPE_AGENT)),
                        c = __uint_as_float(__hip_atomic_load(gp + 2, __ATOMIC_RELAXED, __HIP_MEMORY_SCOPE_AGENT)), d = __uint_as_float(__hip_atomic_load(gp + 3, __ATOMIC_RELAXED, __HIP_MEMORY_SCOPE_AGENT));
            rs[tid] = rsqrtf(((a + b) + (c + d)) * (1.0f / 1024.f) + EPS); }
        asm volatile("s_waitcnt lgkmcnt(0)" ::: "memory"); __builtin_amdgcn_s_barrier(); asm volatile("" ::: "memory");
        return 0.f;
    }
    __device__ __forceinline__ void operator()(const f32x4 (&acc)[2][2][4][2], const Unit& u, int wr, int wc, int fr, int fq) const {
        LAS float* rs = (LAS float*)xl + 1024;
        f32x4 y[2][2][4][2];
        float ss[2][4];
#pragma unroll
        for (int ai = 0; ai < 2; ++ai)
#pragma unroll
            for (int m = 0; m < 4; ++m) { float sacc = 0.f;
#pragma unroll
                for (int bj = 0; bj < 2; ++bj)
#pragma unroll
                    for (int n = 0; n < 2; ++n) { const f32x4 v = acc[ai][bj][m][n]; y[ai][bj][m][n] = v; sacc += (v[0] * v[0] + v[1] * v[1]) + (v[2] * v[2] + v[3] * v[3]); }
                sacc += __shfl_xor(sacc, 16); sacc += __shfl_xor(sacc, 32); ss[ai][m] = sacc; }
        (void)exchange(ss, 0, u, wr, wc, fr, fq);
        const int row0 = u.pm * 256 + wr * 64 + fr, col0 = u.pn * 256 + wc * 32 + 8 * fq;
#pragma unroll
        for (int ai = 0; ai < 2; ++ai)
#pragma unroll
            for (int m = 0; m < 4; ++m) { const int rl = wr * 64 + fr + ai * 128 + m * 16; const float r1 = rs[rl]; const size_t ro = (size_t)(row0 + ai * 128 + m * 16) * 1024; float sacc = 0.f;
#pragma unroll
                for (int bj = 0; bj < 2; ++bj)
#pragma unroll
                    for (int n = 0; n < 2; ++n) { const int c = col0 + bj * 128 + 4 * n; const f32x4 xv = *(const f32x4*)(xin + ro + c), gv = *(const f32x4*)(gpost + c);
                        const f32x4 v = xv + y[ai][bj][m][n] * r1 * gv; y[ai][bj][m][n] = v; *(f32x4*)(xout + ro + c) = v; sacc += (v[0] * v[0] + v[1] * v[1]) + (v[2] * v[2] + v[3] * v[3]); }
                sacc += __shfl_xor(sacc, 16); sacc += __shfl_xor(sacc, 32); ss[ai][m] = sacc; }
        if (!gpre) return;
        (void)exchange(ss, 1, u, wr, wc, fr, fq);
#pragma unroll
        for (int ai = 0; ai < 2; ++ai)
#pragma unroll
            for (int m = 0; m < 4; ++m) { const int rl = wr * 64 + fr + ai * 128 + m * 16; const float r2 = rs[rl]; const size_t ro = (size_t)(row0 + ai * 128 + m * 16) * 1024;
#pragma unroll
                for (int bj = 0; bj < 2; ++bj) { const int c = col0 + bj * 128; const f32x4 g0 = *(const f32x4*)(gpre + c), g1 = *(const f32x4*)(gpre + c + 4);
                    const f32x4 v0 = y[ai][bj][m][0] * r2 * g0, v1 = y[ai][bj][m][1] * r2 * g1;
                    u32x4 w; w.x = cvt_pk_bf16(v0[0], v0[1]); w.y = cvt_pk_bf16(v0[2], v0[3]); w.z = cvt_pk_bf16(v1[0], v1[1]); w.w = cvt_pk_bf16(v1[2], v1[3]);
                    *(u32x4*)(xn + ro + c) = w; } }
    }
};
struct EpiXKV {
    bf16_t* XK; bf16_t* XVT;
    __device__ __forceinline__ void operator()(const f32x4 (&acc)[2][2][4][2], const Unit& u, int wr, int wc, int fr, int fq) const {
        const int row0 = u.pm * 256 + wr * 64 + fr;
        if (u.pn < 4) { EpiPlain e{XK, 1024, 1.0f}; e(acc, u, wr, wc, fr, fq); return; }
        const int hx = u.pn - 4;
#pragma unroll
        for (int ai = 0; ai < 2; ++ai)
#pragma unroll
            for (int m = 0; m < 4; ++m) { const int r = row0 + ai * 128 + m * 16; const int lb = r >> 8, key = r & 255;
                bf16_t* base = XVT + ((size_t)(lb * 4 + hx) * 256) * 256 + key;
#pragma unroll
                for (int bj = 0; bj < 2; ++bj)
#pragma unroll
                    for (int n = 0; n < 2; ++n)
#pragma unroll
                        for (int i = 0; i < 4; ++i) { const int pos = bj * 128 + wc * 32 + 16 * n + 4 * fq + i; base[(size_t)pos * 256] = f2bf(acc[ai][bj][m][n][i]); } }
    }
};
struct EpiSwiGLU {
    bf16_t* F;
    __device__ __forceinline__ void operator()(const f32x4 (&acc)[2][2][4][2], const Unit& u, int wr, int wc, int fr, int fq) const {
        const int row0 = u.pm * 256 + wr * 64 + fr;
#pragma unroll
        for (int ai = 0; ai < 2; ++ai)
#pragma unroll
            for (int m = 0; m < 4; ++m) { bf16_t* rowp = F + (size_t)(row0 + ai * 128 + m * 16) * FF;
#pragma unroll
                for (int bj = 0; bj < 2; ++bj) { const int cc = 64 * (2 * u.pn + bj) + 16 * wc + 4 * fq; const f32x4 g = acc[ai][bj][m][0], up = acc[ai][bj][m][1]; float o[4];
#pragma unroll
                    for (int i = 0; i < 4; ++i) o[i] = g[i] * sigmoidf_(g[i]) * up[i];
                    u32x2 w; w.x = cvt_pk_bf16(o[0], o[1]); w.y = cvt_pk_bf16(o[2], o[3]); *(u32x2*)(rowp + cc) = w; } }
    }
};
struct EpiGates {
    bf16_t* Y; const bf16_t* ya; const bf16_t* yb; const float* gnorm; LAS unsigned char* xl;
    __device__ __forceinline__ void operator()(const f32x4 (&acc)[2][2][4][2], const Unit& u, int wr, int wc, int fr, int fq) const {
        LAS float* sms = (LAS float*)xl;
        const int row0 = u.pm * 256 + wr * 64 + fr, rl0 = wr * 64 + fr;
        u32x2 braw[2][4][2];
#pragma unroll
        for (int ai = 0; ai < 2; ++ai)
#pragma unroll
            for (int m = 0; m < 4; ++m) { const size_t r = (size_t)(row0 + ai * 128 + m * 16); float ss = 0.f;
#pragma unroll
                for (int bj = 0; bj < 2; ++bj) { const int cc = 64 * (2 * u.pn + bj) + 16 * wc + 4 * fq; const u32x2 b = *(const u32x2*)(yb + r * 1024 + cc); braw[ai][m][bj] = b;
                    const float b0 = bflo(b.x), b1 = bfhi(b.x), b2 = bflo(b.y), b3 = bfhi(b.y); ss += (b0 * b0 + b1 * b1) + (b2 * b2 + b3 * b3); }
                ss += __shfl_xor(ss, 16); ss += __shfl_xor(ss, 32);
                if (fq == 0) sms[(rl0 + ai * 128 + m * 16) * 4 + wc] = ss; }
        asm volatile("s_waitcnt lgkmcnt(0)" ::: "memory"); __builtin_amdgcn_s_barrier(); asm volatile("" ::: "memory");
#pragma unroll
        for (int ai = 0; ai < 2; ++ai)
#pragma unroll
            for (int m = 0; m < 4; ++m) { const size_t r = (size_t)(row0 + ai * 128 + m * 16);
                const f32x4 q = *(const LAS f32x4*)(sms + (rl0 + ai * 128 + m * 16) * 4); const float rs = rsqrtf(((q[0] + q[1]) + (q[2] + q[3])) * (1.0f / 128.f) + EPS);
#pragma unroll
                for (int bj = 0; bj < 2; ++bj) { const int cc = 64 * (2 * u.pn + bj) + 16 * wc + 4 * fq; const f32x4 ga = acc[ai][bj][m][0], gb = acc[ai][bj][m][1];
                    const u32x2 a = *(const u32x2*)(ya + r * 1024 + cc), b = braw[ai][m][bj]; const f32x4 gv = *(const f32x4*)(gnorm + (cc & 127));
                    const float av[4] = {bflo(a.x), bfhi(a.x), bflo(a.y), bfhi(a.y)}, bv[4] = {bflo(b.x), bfhi(b.x), bflo(b.y), bfhi(b.y)}; float o[4];
#pragma unroll
                    for (int i = 0; i < 4; ++i) o[i] = sigmoidf_(ga[i]) * av[i] + sigmoidf_(gb[i]) * (bv[i] * rs * gv[i]);
                    u32x2 w; w.x = cvt_pk_bf16(o[0], o[1]); w.y = cvt_pk_bf16(o[2], o[3]); *(u32x2*)(Y + r * 1024 + cc) = w; } }
    }
};
struct EpiInProj {
    KP e; int layer;
    __device__ __forceinline__ void operator()(const f32x4 (&acc)[2][2][4][2], const Unit& u, int wr, int wc, int fr, int fq) const {
        const int row0 = u.pm * 256 + wr * 64 + fr, pn = u.pn;
        if (pn == 5 || pn >= 8) {
            bf16_t* O = (pn == 5) ? e->vb : e->raw + (size_t)((pn - 8) >> 2) * MTOK * 1024 + ((pn - 8) & 3) * 256; const int ldc = (pn == 5) ? 256 : 1024;
#pragma unroll
            for (int ai = 0; ai < 2; ++ai)
#pragma unroll
                for (int m = 0; m < 4; ++m) { bf16_t* rowp = O + (size_t)(row0 + ai * 128 + m * 16) * ldc + wc * 32 + 8 * fq;
#pragma unroll
                    for (int bj = 0; bj < 2; ++bj) { const f32x4 v0 = acc[ai][bj][m][0], v1 = acc[ai][bj][m][1];
                        u32x4 w; w.x = cvt_pk_bf16(v0[0], v0[1]); w.y = cvt_pk_bf16(v0[2], v0[3]); w.z = cvt_pk_bf16(v1[0], v1[1]); w.w = cvt_pk_bf16(v1[2], v1[3]);
                        *(u32x4*)(rowp + bj * 128) = w;
                        if (m == 3 && fr >= 13 && pn >= 8 && pn < 16) {
                            const int r = row0 + ai * 128 + m * 16;
                            *(u32x4*)(e->halo + ((size_t)(r >> 6) * 3 + ((r & 63) - 61)) * 2048 + (pn - 8) * 256 + bj * 128 + wc * 32 + 8 * fq) = w; } } }
            return;
        }
        if (pn < 5) {
            const float sc = (pn < 4) ? 0.08838834764831845f : 1.0f; bf16_t* O = (pn < 4) ? e->qb : e->kb; const int ldc = (pn < 4) ? 1024 : 256; const int d0 = 16 * wc + 4 * fq;
#pragma unroll
            for (int ai = 0; ai < 2; ++ai)
#pragma unroll
                for (int m = 0; m < 4; ++m) { const size_t r = (size_t)(row0 + ai * 128 + m * 16);
                    const f32x4 c = *(const f32x4*)(e->rope_cos + r * 64 + d0), s = *(const f32x4*)(e->rope_sin + r * 64 + d0);
#pragma unroll
                    for (int bj = 0; bj < 2; ++bj) { const int head = (pn < 4) ? 2 * pn + bj : bj; const f32x4 x1 = acc[ai][bj][m][0], x2 = acc[ai][bj][m][1];
                        const f32x4 o1 = (x1 * c - x2 * s) * sc, o2 = (x2 * c + x1 * s) * sc;
                        u32x2 w1, w2; w1.x = cvt_pk_bf16(o1[0], o1[1]); w1.y = cvt_pk_bf16(o1[2], o1[3]); w2.x = cvt_pk_bf16(o2[0], o2[1]); w2.y = cvt_pk_bf16(o2[2], o2[3]);
                        *(u32x2*)(O + r * ldc + head * 128 + d0) = w1; *(u32x2*)(O + r * ldc + head * 128 + 64 + d0) = w2; } }
            return;
        }
        if (pn == 7 && wc >= 2) {
            if (wc == 2) {
#pragma unroll
                for (int ai = 0; ai < 2; ++ai)
#pragma unroll
                    for (int m = 0; m < 4; ++m) { const size_t r = (size_t)(row0 + ai * 128 + m * 16);
#pragma unroll
                        for (int n = 0; n < 2; ++n)
#pragma unroll
                            for (int i = 0; i < 4; ++i) { const int sidx = 16 * n + 4 * fq + i; const float v = acc[ai][0][m][n][i];
                                if (sidx < 4) e->wi[r * 4 + sidx] = v * 0.5f;
                                else if (sidx < 12) { const int h = sidx - 4; const float z = v + e->dt_bias[layer * 8 + h]; const float sp = fmaxf(z, 0.f) + __logf(1.0f + __expf(-fabsf(z))); e->gg[r * 8 + h] = -__expf(e->a_log[layer * 8 + h]) * sp; }
                                else if (sidx < 20) { const int h = sidx - 12; e->beta[r * 8 + h] = sigmoidf_(v); } } }
            }
            return;
        }
        const int d0 = 16 * (wc & 1) + 4 * fq;
#pragma unroll
        for (int ai = 0; ai < 2; ++ai)
#pragma unroll
            for (int m = 0; m < 4; ++m) { const size_t r = (size_t)(row0 + ai * 128 + m * 16);
                const f32x4 ca = *(const f32x4*)(e->rope_cos + r * 64 + 2 * d0), cb = *(const f32x4*)(e->rope_cos + r * 64 + 2 * d0 + 4);
                const f32x4 sa = *(const f32x4*)(e->rope_sin + r * 64 + 2 * d0), sb = *(const f32x4*)(e->rope_sin + r * 64 + 2 * d0 + 4);
                const f32x4 c = (f32x4){ca[0], ca[2], cb[0], cb[2]}, s = (f32x4){sa[0], sa[2], sb[0], sb[2]};
                if (pn == 6) {
#pragma unroll
                    for (int bj = 0; bj < 2; ++bj) { const int head = 2 * bj + (wc >> 1); const f32x4 x1 = acc[ai][bj][m][0], x2 = acc[ai][bj][m][1];
                        const f32x4 o1 = (x1 * c - x2 * s) * 0.125f, o2 = (x2 * c + x1 * s) * 0.125f;
                        u32x2 w1, w2; w1.x = cvt_pk_bf16(o1[0], o1[1]); w1.y = cvt_pk_bf16(o1[2], o1[3]); w2.x = cvt_pk_bf16(o2[0], o2[1]); w2.y = cvt_pk_bf16(o2[2], o2[3]);
                        *(u32x2*)(e->qib + r * 256 + head * 64 + d0) = w1; *(u32x2*)(e->qib + r * 256 + head * 64 + 32 + d0) = w2; }
                } else {
                    const f32x4 x1 = acc[ai][0][m][0], x2 = acc[ai][0][m][1];
                    const f32x4 o1 = x1 * c - x2 * s, o2 = x2 * c + x1 * s;
                    u32x2 w1, w2; w1.x = cvt_pk_bf16(o1[0], o1[1]); w1.y = cvt_pk_bf16(o1[2], o1[3]); w2.x = cvt_pk_bf16(o2[0], o2[1]); w2.y = cvt_pk_bf16(o2[2], o2[3]);
                    *(u32x2*)(e->kib + r * 64 + d0) = w1; *(u32x2*)(e->kib + r * 64 + 32 + d0) = w2;
                }
            }
    }
};

__device__ __forceinline__ void phase_gdn_prep(KP p, int layer, LAS unsigned char* lds) {
    const int tid = tid_opaque(), lane0 = tid & 63, wid = __builtin_amdgcn_readfirstlane(tid >> 6);
    LAS float* Ms = (LAS float*)(lds + wid * 16896);
    LAS float* gcs = Ms + 4096;
    const float* cw = p->conv_w + (size_t)layer * 4 * 3072;
    for (int item = blockIdx.x * NWAVES + wid; item < 4096; item += gridDim.x * NWAVES) {
        int lane = lane0; asm volatile("" : "+v"(lane));
        const int n = lane & 15, g = lane >> 4;
        const int c = item & 255, h = (item >> 8) & 7, b = item >> 11;
        const size_t m0 = (size_t)b * SEQ + 64 * c;
#pragma unroll 1
        for (int which = 0; which < 2; ++which) {
            bf16_t* rp = p->raw + (size_t)which * MTOK * 1024 + m0 * 1024 + h * 128 + 2 * lane;
            const int cc = which * 1024 + h * 128 + 2 * lane;
            float w[4][2];
#pragma unroll
            for (int j = 0; j < 4; ++j) { w[j][0] = cw[j * 3072 + cc]; w[j][1] = cw[j * 3072 + cc + 1]; }
            float hs[3][2];
#pragma unroll
            for (int j = 0; j < 3; ++j) { hs[j][0] = 0.f; hs[j][1] = 0.f; }
            if (c > 0) { const bf16_t* hp = p->halo + ((size_t)(m0 / 64 - 1) * 3) * 2048 + cc;
#pragma unroll
                for (int j = 0; j < 3; ++j) { const unsigned u = *(const unsigned*)(hp + j * 2048); hs[j][0] = bflo(u); hs[j][1] = bfhi(u); } }
            const float post = which == 0 ? 0.08838834764831845f : 1.0f;
            unsigned raw64[64];
#pragma unroll
            for (int r = 0; r < 64; ++r) raw64[r] = *(const unsigned*)(rp + (size_t)r * 1024);
#pragma unroll
            for (int r = 0; r < 64; ++r) {
                const float x0 = bflo(raw64[r]), x1 = bfhi(raw64[r]);
                float y0 = w[0][0] * hs[0][0] + w[1][0] * hs[1][0] + w[2][0] * hs[2][0] + w[3][0] * x0;
                float y1 = w[0][1] * hs[0][1] + w[1][1] * hs[1][1] + w[2][1] * hs[2][1] + w[3][1] * x1;
                hs[0][0] = hs[1][0]; hs[1][0] = hs[2][0]; hs[2][0] = x0; hs[0][1] = hs[1][1]; hs[1][1] = hs[2][1]; hs[2][1] = x1;
                y0 = y0 * sigmoidf_(y0); y1 = y1 * sigmoidf_(y1);
                const float ss = wave_sum(y0 * y0 + y1 * y1);
                const float rs = rsqrtf(ss + EPS) * post;
                *(unsigned*)(rp + (size_t)r * 1024) = cvt_pk_bf16(y0 * rs, y1 * rs);
            }
        }
        float gcv = p->gg[(m0 + lane) * 8 + h];
#pragma unroll
        for (int o = 1; o < 64; o <<= 1) { const float t = __shfl_up(gcv, o); if (lane >= o) gcv += t; }
        const float bev = p->beta[(m0 + lane) * 8 + h];
        p->gg[(m0 + lane) * 8 + h] = gcv;
        gcs[lane] = gcv; gcs[64 + lane] = bev;
        asm volatile("s_waitcnt vmcnt(0)" ::: "memory");
        bf16x8 kf[4][4];
        const bf16_t* kq = p->raw + m0 * 1024 + h * 128 + 8 * g + (size_t)n * 1024;
#pragma unroll
        for (int mt = 0; mt < 4; ++mt)
#pragma unroll
            for (int ks = 0; ks < 4; ++ks) kf[mt][ks] = *(const bf16x8*)(kq + (size_t)MTOK * 1024 + (size_t)mt * 16 * 1024 + 32 * ks);
        bf16_t* tout = (layer == 0 ? (bf16_t*)p->out : p->ta) + (size_t)item * 8192; bf16_t* aout = tout + 4096;
#pragma unroll
        for (int mt = 0; mt < 4; ++mt) {
            bf16x8 qf[4];
#pragma unroll
            for (int ks = 0; ks < 4; ++ks) qf[ks] = *(const bf16x8*)(kq + (size_t)mt * 16 * 1024 + 32 * ks);
            const f32x4 gi = *(const LAS f32x4*)(gcs + 16 * mt + 4 * g), bi = *(const LAS f32x4*)(gcs + 64 + 16 * mt + 4 * g);
#pragma unroll
            for (int nt = 0; nt < 4; ++nt) {
                f32x4 aK = (f32x4){0.f, 0.f, 0.f, 0.f}, aQ = (f32x4){0.f, 0.f, 0.f, 0.f};
                if (nt <= mt) {
#pragma unroll
                    for (int ks = 0; ks < 4; ++ks) { aK = __builtin_amdgcn_mfma_f32_16x16x32_bf16(kf[mt][ks], kf[nt][ks], aK, 0, 0, 0); aQ = __builtin_amdgcn_mfma_f32_16x16x32_bf16(qf[ks], kf[nt][ks], aQ, 0, 0, 0); }
                }
                const float gj = gcs[16 * nt + n]; const int j = 16 * nt + n;
#pragma unroll
                for (int r = 0; r < 4; ++r) { const int i = 16 * mt + 4 * g + r;
                    const float dec = (j <= i) ? __expf(gi[r] - gj) : 0.f;
                    Ms[i * 64 + j] = (j < i) ? bi[r] * aK[r] * dec : 0.f;
                    aout[i * 64 + j] = f2bf(aQ[r] * dec); }
            }
        }
        float Tc[64];
#pragma unroll
        for (int i = 0; i < 64; ++i) {
            float acc = (lane == i) ? 1.f : 0.f;
#pragma unroll
            for (int j4 = 0; j4 < i; j4 += 4) { const f32x4 mv = *(const LAS f32x4*)(Ms + i * 64 + j4);
#pragma unroll
                for (int jj = 0; jj < 4; ++jj) if (j4 + jj < i) acc -= mv[jj] * Tc[j4 + jj]; }
            Tc[i] = acc;
            tout[i * 64 + lane] = f2bf(acc);
            asm volatile("" ::: "memory");
        }
    }
}

__device__ __forceinline__ unsigned lds_addr32(LAS unsigned char* q) { return (unsigned)(unsigned long)q; }
__device__ __forceinline__ void glds16_asm(const void* gsrc, unsigned lds_dst) {
    unsigned keep; const unsigned dst = (unsigned)__builtin_amdgcn_readfirstlane((int)lds_dst);
    asm volatile("s_mov_b32 %0, m0\n\ts_mov_b32 m0, %2\n\ts_nop 0\n\tglobal_load_lds_dwordx4 %1, off\n\ts_mov_b32 m0, %0" : "=&s"(keep) : "v"(gsrc), "s"(dst) : "memory");
}
__device__ __forceinline__ void ds_read_b128_x2(u32x4& r0, u32x4& r1, unsigned a0, unsigned a1, const int off) {
    asm volatile("ds_read_b128 %0, %2 offset:%4\n\tds_read_b128 %1, %3 offset:%4\n\ts_waitcnt lgkmcnt(0)" : "=&v"(r0), "=&v"(r1) : "v"(a0), "v"(a1), "i"(off) : "memory");
}
__device__ __forceinline__ void glds16x2_s(const void* sbase, unsigned voff, unsigned lds_dst) {
    unsigned keep;
    asm volatile("s_mov_b32 %0, m0\n\ts_mov_b32 m0, %3\n\ts_nop 0\n\tglobal_load_lds_dwordx4 %1, %2\n\tglobal_load_lds_dwordx4 %1, %2 offset:1024\n\ts_mov_b32 m0, %0"
                 : "=&s"(keep) : "v"(voff), "s"(sbase), "s"(lds_dst) : "memory");
}
__device__ __forceinline__ void glds16_s2(const void* sa, const void* sb, unsigned voff, unsigned lds_a, unsigned lds_b) {
    unsigned keep;
    asm volatile("s_mov_b32 %0, m0\n\ts_mov_b32 m0, %4\n\ts_nop 0\n\tglobal_load_lds_dwordx4 %1, %2\n\ts_mov_b32 m0, %5\n\ts_nop 0\n\tglobal_load_lds_dwordx4 %1, %3\n\ts_mov_b32 m0, %0"
                 : "=&s"(keep) : "v"(voff), "s"(sa), "s"(sb), "s"(lds_a), "s"(lds_b) : "memory");
}
__device__ __forceinline__ void glds16_s4(const void* sbase, unsigned voff, unsigned lds_dst) {
    unsigned keep;
    asm volatile("s_mov_b32 %0, m0\n\ts_mov_b32 m0, %3\n\ts_nop 0\n\tglobal_load_lds_dwordx4 %1, %2\n\tglobal_load_lds_dwordx4 %1, %2 offset:1024\n\tglobal_load_lds_dwordx4 %1, %2 offset:2048\n\tglobal_load_lds_dwordx4 %1, %2 offset:3072\n\ts_mov_b32 m0, %0"
                 : "=&s"(keep) : "v"(voff), "s"(sbase), "s"(lds_dst) : "memory");
}
__device__ __forceinline__ void glds4_s2(const void* sa, const void* sb, unsigned voff, unsigned lds_a, unsigned lds_b) {
    unsigned keep;
    asm volatile("s_mov_b32 %0, m0\n\ts_mov_b32 m0, %4\n\ts_nop 0\n\tglobal_load_lds_dword %1, %2\n\ts_mov_b32 m0, %5\n\ts_nop 0\n\tglobal_load_lds_dword %1, %3\n\ts_mov_b32 m0, %0"
                 : "=&s"(keep) : "v"(voff), "s"(sa), "s"(sb), "s"(lds_a), "s"(lds_b) : "memory");
}
__device__ __forceinline__ void ds_read_tr16_b64_x8(u32x2 (&r)[8], const unsigned (&a)[8]) {
    asm volatile("ds_read_b64_tr_b16 %0, %8\n\tds_read_b64_tr_b16 %1, %9\n\tds_read_b64_tr_b16 %2, %10\n\tds_read_b64_tr_b16 %3, %11\n\t"
                 "ds_read_b64_tr_b16 %4, %12\n\tds_read_b64_tr_b16 %5, %13\n\tds_read_b64_tr_b16 %6, %14\n\tds_read_b64_tr_b16 %7, %15\n\ts_waitcnt lgkmcnt(0)"
                 : "=&v"(r[0]), "=&v"(r[1]), "=&v"(r[2]), "=&v"(r[3]), "=&v"(r[4]), "=&v"(r[5]), "=&v"(r[6]), "=&v"(r[7])
                 : "v"(a[0]), "v"(a[1]), "v"(a[2]), "v"(a[3]), "v"(a[4]), "v"(a[5]), "v"(a[6]), "v"(a[7]) : "memory");
}
__device__ __forceinline__ void ds_read_tr16_b64_x4(u32x2& r0, u32x2& r1, u32x2& r2, u32x2& r3, unsigned a0, unsigned a1, unsigned a2, unsigned a3) {
    asm volatile("ds_read_b64_tr_b16 %0, %4\n\tds_read_b64_tr_b16 %1, %5\n\tds_read_b64_tr_b16 %2, %6\n\tds_read_b64_tr_b16 %3, %7\n\ts_waitcnt lgkmcnt(0)"
                 : "=&v"(r0), "=&v"(r1), "=&v"(r2), "=&v"(r3) : "v"(a0), "v"(a1), "v"(a2), "v"(a3) : "memory");
}
constexpr int SC_K = 0, SC_Q = 16384, SC_T = 32768, SC_A = 40960, SC_S = 49152, SC_BUF = 49664;
constexpr int SC_VT = 2 * SC_BUF, SC_END = SC_VT + 2 * 4096;
constexpr unsigned SC_SPIN_CAP = 1u << 22;
#define SC_WAIT(flag, val) do { unsigned _sp = 0; while (*(flag) < (unsigned)(val) && ++_sp < SC_SPIN_CAP) __builtin_amdgcn_s_sleep(1); } while (0)
__device__ __forceinline__ void gdn_scan_issuer(KP p, int layer, int unit, LAS unsigned char* lds, int lane0, volatile LAS unsigned* f_dma, volatile LAS unsigned* f_done, unsigned fbase) {
    const int h = (unit >> 3) & 7, b = unit >> 6;
    const size_t mb = (size_t)b * SEQ;
    const bf16_t* rq = p->raw + h * 128; const bf16_t* rk = rq + (size_t)MTOK * 1024;
    const bf16_t* tab = (layer == 0 ? (const bf16_t*)p->out : p->ta) + (size_t)((b * 8 + h) * 256) * 8192;
    unsigned vo_kq[4];
#pragma unroll
    for (int j = 0; j < 4; ++j) vo_kq[j] = (unsigned)((lane0 >> 4) * 2048 + 16 * ((lane0 & 15) ^ ((4 * j + (lane0 >> 4)) & 15)));
    const unsigned vo_ta = (unsigned)((lane0 >> 3) * 128 + 16 * ((lane0 & 7) ^ ((lane0 >> 3) & 7))), vo_g = (unsigned)(lane0 * 32);
    const unsigned ldsS = (unsigned)__builtin_amdgcn_readfirstlane((int)lds_addr32(lds));
    for (int c = 0; c < 256; ++c) {
        if (c >= 2) SC_WAIT(f_done, fbase + c - 1);
        const size_t m0 = mb + 64 * (size_t)c; const unsigned l_ = ldsS + (c & 1) * SC_BUF;
        const char* sk = (const char*)(rk + m0 * 1024); const char* sq = (const char*)(rq + m0 * 1024);
#pragma unroll
        for (int i = 0; i < 16; ++i) glds16_s2(sk + i * 8192, sq + i * 8192, vo_kq[i & 3], l_ + SC_K + i * 1024, l_ + SC_Q + i * 1024);
        { const char* t = (const char*)(tab + (size_t)c * 8192);
          glds16_s4(t, vo_ta, l_ + SC_T); glds16_s4(t + 4096, vo_ta, l_ + SC_T + 4096); glds16_s4(t + 8192, vo_ta, l_ + SC_A); glds16_s4(t + 12288, vo_ta, l_ + SC_A + 4096); }
        glds4_s2(p->gg + m0 * 8 + h, p->beta + m0 * 8 + h, vo_g, l_ + SC_S, l_ + SC_S + 256);
        asm volatile("s_waitcnt vmcnt(0)" ::: "memory");
        *f_dma = fbase + (unsigned)c + 1u;
    }
}
__device__ __forceinline__ void gdn_scan_conv(KP p, int layer, int unit, LAS unsigned char* lds, int lane0, volatile LAS unsigned* f_dma, volatile LAS unsigned* f_vr, volatile LAS unsigned* f_done, unsigned fbase) {
    const int n = lane0 & 15, g = lane0 >> 4;
    const int cb = unit & 7, h = (unit >> 3) & 7, b = unit >> 6;
    const size_t mb = (size_t)b * SEQ;
    const bf16_t* rv = p->raw + (size_t)MTOK * 2048 + h * 128 + 16 * cb + n;
    const float* cw = p->conv_w + (size_t)layer * 4 * 3072 + 2048 + h * 128 + 16 * cb + n;
    const float wv0 = cw[0], wv1 = cw[3072], wv2 = cw[2 * 3072], wv3 = cw[3 * 3072];
    unsigned short xn[4][7];
    float pv[3] = {0.f, 0.f, 0.f};
#define SCV_LOAD(c) do { const size_t _m0 = mb + 64 * (size_t)(c); _Pragma("unroll") for (int _mt = 0; _mt < 4; ++_mt) _Pragma("unroll") for (int _k = 0; _k < 7; ++_k) { \
        const int _tok = 16 * _mt + 4 * g - 3 + _k; xn[_mt][_k] = rv[(_m0 + (size_t)(_tok < 0 ? 0 : _tok)) * 1024]; } } while (0)
    SCV_LOAD(0);
    for (int c = 0; c < 256; ++c) {
        float x[4][7];
#pragma unroll
        for (int mt = 0; mt < 4; ++mt)
#pragma unroll
            for (int k = 0; k < 7; ++k) x[mt][k] = bf2f(xn[mt][k]);
        asm volatile("" ::: "memory");
        if (c + 1 < 256) SCV_LOAD(c + 1);
#pragma unroll
        for (int k = 0; k < 3; ++k) if (4 * g - 3 + k < 0) x[0][k] = pv[k];
        f32x4 vt[4];
#pragma unroll
        for (int mt = 0; mt < 4; ++mt)
#pragma unroll
            for (int r = 0; r < 4; ++r) { const float y = wv0 * x[mt][r] + wv1 * x[mt][r + 1] + wv2 * x[mt][r + 2] + wv3 * x[mt][r + 3]; vt[mt][r] = y * sigmoidf_(y); }
#pragma unroll
        for (int k = 0; k < 3; ++k) pv[k] = __shfl(x[3][4 + k], 48 + n);
        if (c >= 2) SC_WAIT(f_done, fbase + c - 1);
        LAS unsigned char* slot = lds + SC_VT + (c & 1) * 4096;
#pragma unroll
        for (int mt = 0; mt < 4; ++mt) *(LAS f32x4*)(slot + ((mt * 4 + g) * 16 + n) * 16) = vt[mt];
        asm volatile("s_waitcnt lgkmcnt(0)" ::: "memory");
        SC_WAIT(f_dma, fbase + c + 1);
        *f_vr = fbase + (unsigned)c + 1u;
    }
#undef SCV_LOAD
}
__device__ __forceinline__ void gdn_scan_unit(KP p, int unit, LAS unsigned char* lds, int lane0, volatile LAS unsigned* f_vr, volatile LAS unsigned* f_done, unsigned fbase) {
    int lane = lane0; const int n = lane0 & 15, g = lane0 >> 4;
    const int cb = unit & 7, h = (unit >> 3) & 7, b = unit >> 6;
    const size_t mb = (size_t)b * SEQ;
    bf16_t* rv = p->raw + (size_t)MTOK * 2048 + h * 128 + 16 * cb;
    f32x4 S[8];
#pragma unroll
    for (int t = 0; t < 8; ++t) S[t] = (f32x4){0.f, 0.f, 0.f, 0.f};
    for (int c = 0; c < 256; ++c) {
        const int buf = c & 1; LAS unsigned char* L = lds + buf * SC_BUF;
        asm volatile("" : "+v"(lane));
        SC_WAIT(f_vr, fbase + c + 1);
        asm volatile("" ::: "memory");
        const float gcl = ((const LAS float*)(L + SC_S))[63];
        f32x4 vt[4];
        { const LAS unsigned char* slot = lds + SC_VT + buf * 4096;
#pragma unroll
          for (int mt = 0; mt < 4; ++mt) vt[mt] = *(const LAS f32x4*)(slot + ((mt * 4 + g) * 16 + n) * 16); }
        bf16x8 bS[4];
#pragma unroll
        for (int ks = 0; ks < 4; ++ks) { u32x4 w; w.x = cvt_pk_bf16(S[2 * ks][0], S[2 * ks][1]); w.y = cvt_pk_bf16(S[2 * ks][2], S[2 * ks][3]); w.z = cvt_pk_bf16(S[2 * ks + 1][0], S[2 * ks + 1][1]); w.w = cvt_pk_bf16(S[2 * ks + 1][2], S[2 * ks + 1][3]); bS[ks] = __builtin_bit_cast(bf16x8, w); }
#define SC_AFRAG128(IMG, mt, ks) ({ const int _row = 16 * (mt) + n; const LAS unsigned char* _b = L + (IMG) + _row * 256 + 8 * (g & 1); \
        const u32x2 _lo = *(const LAS u32x2*)(_b + 16 * ((4 * (ks) + (g >> 1)) ^ (_row & 15))), _hi = *(const LAS u32x2*)(_b + 16 * ((4 * (ks) + 2 + (g >> 1)) ^ (_row & 15))); \
        __builtin_bit_cast(bf16x8, (u32x4){_lo.x, _lo.y, _hi.x, _hi.y}); })
#define SC_AFRAG64(IMG, mt, ks) ({ const int _row = 16 * (mt) + n; const LAS unsigned char* _b = L + (IMG) + _row * 128 + 8 * (g & 1); \
        const u32x2 _lo = *(const LAS u32x2*)(_b + 16 * ((4 * (ks) + (g >> 1)) ^ (_row & 7))), _hi = *(const LAS u32x2*)(_b + 16 * ((4 * (ks) + 2 + (g >> 1)) ^ (_row & 7))); \
        __builtin_bit_cast(bf16x8, (u32x4){_lo.x, _lo.y, _hi.x, _hi.y}); })
        f32x4 KS[4], QS[4];
#pragma unroll
        for (int mt = 0; mt < 4; ++mt) { KS[mt] = (f32x4){0.f, 0.f, 0.f, 0.f}; QS[mt] = (f32x4){0.f, 0.f, 0.f, 0.f};
#pragma unroll
            for (int ks = 0; ks < 4; ++ks) { KS[mt] = __builtin_amdgcn_mfma_f32_16x16x32_bf16(SC_AFRAG128(SC_K, mt, ks), bS[ks], KS[mt], 0, 0, 0); QS[mt] = __builtin_amdgcn_mfma_f32_16x16x32_bf16(SC_AFRAG128(SC_Q, mt, ks), bS[ks], QS[mt], 0, 0, 0); } }
        f32x4 eg[4];
        bf16x8 bR[2];
        { f32x4 Rb[4];
#pragma unroll
          for (int mt = 0; mt < 4; ++mt) { const f32x4 gc4 = *(const LAS f32x4*)(L + SC_S + 4 * (16 * mt + 4 * g)), be4 = *(const LAS f32x4*)(L + SC_S + 256 + 4 * (16 * mt + 4 * g));
#pragma unroll
              for (int r = 0; r < 4; ++r) { eg[mt][r] = __expf(gc4[r]); Rb[mt][r] = be4[r] * (vt[mt][r] - eg[mt][r] * KS[mt][r]); QS[mt][r] *= eg[mt][r]; } }
#pragma unroll
          for (int ks = 0; ks < 2; ++ks) { u32x4 w; w.x = cvt_pk_bf16(Rb[2 * ks][0], Rb[2 * ks][1]); w.y = cvt_pk_bf16(Rb[2 * ks][2], Rb[2 * ks][3]); w.z = cvt_pk_bf16(Rb[2 * ks + 1][0], Rb[2 * ks + 1][1]); w.w = cvt_pk_bf16(Rb[2 * ks + 1][2], Rb[2 * ks + 1][3]); bR[ks] = __builtin_bit_cast(bf16x8, w); } }
        f32x4 vn[4];
#pragma unroll
        for (int mt = 0; mt < 4; ++mt) { vn[mt] = (f32x4){0.f, 0.f, 0.f, 0.f};
#pragma unroll
            for (int ks = 0; ks < 2; ++ks) vn[mt] = __builtin_amdgcn_mfma_f32_16x16x32_bf16(SC_AFRAG64(SC_T, mt, ks), bR[ks], vn[mt], 0, 0, 0); }
        bf16x8 bV[2], bVS[2];
#pragma unroll
        for (int ks = 0; ks < 2; ++ks) { u32x4 w; w.x = cvt_pk_bf16(vn[2 * ks][0], vn[2 * ks][1]); w.y = cvt_pk_bf16(vn[2 * ks][2], vn[2 * ks][3]); w.z = cvt_pk_bf16(vn[2 * ks + 1][0], vn[2 * ks + 1][1]); w.w = cvt_pk_bf16(vn[2 * ks + 1][2], vn[2 * ks + 1][3]); bV[ks] = __builtin_bit_cast(bf16x8, w);
            const f32x4 ga = *(const LAS f32x4*)(L + SC_S + 4 * (32 * ks + 4 * g)), gb2 = *(const LAS f32x4*)(L + SC_S + 4 * (32 * ks + 16 + 4 * g));
            f32x4 ea, eb;
#pragma unroll
            for (int r = 0; r < 4; ++r) { ea[r] = vn[2 * ks][r] * __expf(gcl - ga[r]); eb[r] = vn[2 * ks + 1][r] * __expf(gcl - gb2[r]); }
            u32x4 z; z.x = cvt_pk_bf16(ea[0], ea[1]); z.y = cvt_pk_bf16(ea[2], ea[3]); z.z = cvt_pk_bf16(eb[0], eb[1]); z.w = cvt_pk_bf16(eb[2], eb[3]); bVS[ks] = __builtin_bit_cast(bf16x8, z); }
        { const size_t m0 = mb + 64 * (size_t)c;
#pragma unroll
          for (int mt = 0; mt < 4; ++mt) {
#pragma unroll
              for (int ks = 0; ks < 2; ++ks) QS[mt] = __builtin_amdgcn_mfma_f32_16x16x32_bf16(SC_AFRAG64(SC_A, mt, ks), bV[ks], QS[mt], 0, 0, 0);
#pragma unroll
              for (int r = 0; r < 4; ++r) rv[(m0 + 16 * mt + 4 * g + r) * 1024 + n] = f2bf(QS[mt][r]); } }
        { const float egl = __expf(gcl); const int q4 = (lane & 15) >> 2, p4 = lane & 3; const unsigned kbase = lds_addr32(L + SC_K) + 8 * (p4 & 1);
#pragma unroll
          for (int t = 0; t < 8; t += 2) {
              u32x2 f[8]; unsigned fa[8];
#pragma unroll
              for (int tt = 0; tt < 2; ++tt)
#pragma unroll
                  for (int ks = 0; ks < 2; ++ks)
#pragma unroll
                      for (int u = 0; u < 2; ++u) { const int row = 32 * ks + 16 * u + 4 * g + q4; fa[tt * 4 + ks * 2 + u] = kbase + row * 256 + 16 * ((2 * (t + tt) + (p4 >> 1)) ^ (row & 15)); }
              ds_read_tr16_b64_x8(f, fa);
#pragma unroll
              for (int tt = 0; tt < 2; ++tt) {
                  S[t + tt] = S[t + tt] * egl;
#pragma unroll
                  for (int ks = 0; ks < 2; ++ks) S[t + tt] = __builtin_amdgcn_mfma_f32_16x16x32_bf16(__builtin_bit_cast(bf16x8, (u32x4){f[tt * 4 + ks * 2].x, f[tt * 4 + ks * 2].y, f[tt * 4 + ks * 2 + 1].x, f[tt * 4 + ks * 2 + 1].y}), bVS[ks], S[t + tt], 0, 0, 0);
              }
          } }
        asm volatile("s_waitcnt lgkmcnt(0)" ::: "memory");
        *f_done = fbase + (unsigned)c + 1u;
    }
#undef SC_AFRAG128
#undef SC_AFRAG64
}


constexpr int SA_LDS_WAVE = 16384;
template <bool DB> __device__ __forceinline__ void phase_sparse_attn(KP p, unsigned* counter, unsigned qx, LAS unsigned char* wl, int lane) {
    const int n = lane & 15, gq = lane >> 4, q4 = n >> 2, p4 = n & 3;
    constexpr unsigned NITEMS = (unsigned)(MTOK * 2);
    unsigned raw = 0;
    if (lane == 0) raw = __hip_atomic_fetch_add(counter, 1u, __ATOMIC_RELAXED, __HIP_MEMORY_SCOPE_AGENT);
    unsigned it = (unsigned)__builtin_amdgcn_readfirstlane((int)raw) * 64u + qx;
    if (it >= NITEMS) return;
    if (lane == 0) raw = __hip_atomic_fetch_add(counter, 1u, __ATOMIC_RELAXED, __HIP_MEMORY_SCOPE_AGENT);
    const bf16_t* selrow; const bf16_t* kbase; const bf16_t* vbase; bf16_t* qrow;
#define SA_DECODE(IT) do { const int _bg = (int)((IT) / SEQ), _t = (int)((IT) % SEQ), _b = _bg >> 1, _gk = _bg & 1; const size_t _m = (size_t)_b * SEQ + _t; \
        selrow = p->sel + _m * TOPK; kbase = p->kb + (size_t)_b * SEQ * 256 + _gk * 128 + 8 * gq; vbase = p->vb + (size_t)_b * SEQ * 256 + _gk * 128; qrow = p->qb + _m * 1024 + _gk * 512; } while (0)
#define SA_ISSUE_V(c, BUF) do { LAS unsigned char* _d = wl + (BUF) * 8192; \
        _Pragma("unroll") for (int _i = 0; _i < 8; ++_i) { const int _r = 4 * _i + gq; unsigned _s = selrow[32 * (c) + _r]; _s = (_s == 0xFFFFu) ? 0u : _s; \
            __builtin_amdgcn_global_load_lds((const unsigned*)(vbase + (size_t)_s * 256 + 8 * (n ^ (_r & 15))), (LAS unsigned*)(_d + _i * 1024), 16, 0, 0); } } while (0)
#define SA_LOAD_SKQ() do { _Pragma("unroll") for (int _kt = 0; _kt < 16; _kt += 2) { unsigned _t0 = selrow[16 * _kt + n], _t1 = selrow[16 * _kt + 16 + n]; _t0 = (_t0 == 0xFFFFu) ? 0u : _t0; _t1 = (_t1 == 0xFFFFu) ? 0u : _t1; sk[_kt >> 1] = _t0 | (_t1 << 16); } \
        _Pragma("unroll") for (int _ks = 0; _ks < 4; ++_ks) { u32x4 _w = (u32x4){0u, 0u, 0u, 0u}; if (n < 4) _w = __builtin_nontemporal_load((const u32x4*)(qrow + n * 128 + 32 * _ks + 8 * gq)); bQ[_ks] = __builtin_bit_cast(bf16x8, _w); } } while (0)
#define SA_LOADK(kt) do { const bf16_t* _kr = kbase + (size_t)(((kt) & 1) ? (sk[(kt) >> 1] >> 16) : (sk[(kt) >> 1] & 0xffffu)) * 256; _Pragma("unroll") for (int _ks = 0; _ks < 4; ++_ks) kf[(kt) % 3][_ks] = *(const bf16x8*)(_kr + 32 * _ks); } while (0)
#define SA_FENCE() asm volatile("" ::: "memory")
    unsigned sk[8]; bf16x8 bQ[4]; bf16x8 kf[3][4];
    SA_DECODE(it);
    SA_ISSUE_V(0, 0); if (DB) SA_ISSUE_V(1, 1);
    SA_FENCE(); SA_LOAD_SKQ(); SA_LOADK(0); SA_LOADK(1); SA_LOADK(2); SA_FENCE();
    for (;;) {
        f32x4 ST[16];
        float mx = -INFINITY;
#pragma unroll
        for (int kt = 0; kt < 16; ++kt) {
            f32x4 acc = (f32x4){0.f, 0.f, 0.f, 0.f};
#pragma unroll
            for (int ks = 0; ks < 4; ++ks) acc = __builtin_amdgcn_mfma_f32_16x16x32_bf16(kf[kt % 3][ks], bQ[ks], acc, 0, 0, 0);
            if (kt + 3 < 16) SA_LOADK(kt + 3);
            const u32x2 sv = *(const u32x2*)(selrow + 16 * kt + 4 * gq);
            const bool v0 = (sv.x & 0xffffu) != 0xffffu, v1 = (sv.x >> 16) != 0xffffu, v2 = (sv.y & 0xffffu) != 0xffffu, v3 = (sv.y >> 16) != 0xffffu;
            acc[0] = v0 ? acc[0] : -INFINITY; acc[1] = v1 ? acc[1] : -INFINITY; acc[2] = v2 ? acc[2] : -INFINITY; acc[3] = v3 ? acc[3] : -INFINITY;
            ST[kt] = acc; mx = fmaxf(fmaxf(mx, fmaxf(acc[0], acc[1])), fmaxf(acc[2], acc[3]));
        }
        mx = fmaxf(mx, __shfl_xor(mx, 16)); mx = fmaxf(mx, __shfl_xor(mx, 32));
        float sum = 0.f;
#pragma unroll
        for (int kt = 0; kt < 16; ++kt)
#pragma unroll
            for (int r = 0; r < 4; ++r) { const float e = __expf(ST[kt][r] - mx); ST[kt][r] = e; sum += e; }
        sum += __shfl_xor(sum, 16); sum += __shfl_xor(sum, 32);
        const float inv = 1.0f / sum;
        bf16_t* const qcur = qrow; const bf16_t* const selcur = selrow; const bf16_t* const vcur = vbase;
        const unsigned nxt = (unsigned)__builtin_amdgcn_readfirstlane((int)raw) * 64u + qx;
        const bool valid = nxt < NITEMS;
        if (valid) { if (lane == 0) raw = __hip_atomic_fetch_add(counter, 1u, __ATOMIC_RELAXED, __HIP_MEMORY_SCOPE_AGENT); }
        SA_FENCE();
        if (valid) { SA_DECODE(nxt); SA_LOAD_SKQ(); }
        SA_FENCE();
        f32x4 OT[8];
#pragma unroll
        for (int dt = 0; dt < 8; ++dt) OT[dt] = (f32x4){0.f, 0.f, 0.f, 0.f};
#pragma unroll
        for (int c = 0; c < 8; ++c) {
            if (DB) { if (c <= 1) { if (valid) asm volatile("s_waitcnt vmcnt(21)" ::: "memory"); else asm volatile("s_waitcnt vmcnt(0)" ::: "memory"); }
                      else if (c <= 4) asm volatile("s_waitcnt vmcnt(8)" ::: "memory");
                      else if (c <= 6) { if (valid) asm volatile("s_waitcnt vmcnt(20)" ::: "memory"); else asm volatile("s_waitcnt vmcnt(8)" ::: "memory"); }
                      else { if (valid) asm volatile("s_waitcnt vmcnt(8)" ::: "memory"); else asm volatile("s_waitcnt vmcnt(0)" ::: "memory"); } }
            else { if (c == 5 && valid) asm volatile("s_waitcnt vmcnt(12)" ::: "memory"); else asm volatile("s_waitcnt vmcnt(0)" ::: "memory"); }
            u32x4 w; w.x = cvt_pk_bf16(ST[2 * c][0], ST[2 * c][1]); w.y = cvt_pk_bf16(ST[2 * c][2], ST[2 * c][3]); w.z = cvt_pk_bf16(ST[2 * c + 1][0], ST[2 * c + 1][1]); w.w = cvt_pk_bf16(ST[2 * c + 1][2], ST[2 * c + 1][3]);
            const bf16x8 bP = __builtin_bit_cast(bf16x8, w);
            const unsigned vb0 = lds_addr32(wl + (DB ? (c & 1) * 8192 : 0)) + 8 * (p4 & 1);
#pragma unroll
            for (int dt = 0; dt < 8; dt += 2) {
                u32x2 f00, f01, f10, f11;
                const int r0 = 4 * gq + q4, r1 = 16 + 4 * gq + q4;
                ds_read_tr16_b64_x4(f00, f01, f10, f11,
                    vb0 + r0 * 256 + 16 * ((2 * dt + (p4 >> 1)) ^ (r0 & 15)), vb0 + r1 * 256 + 16 * ((2 * dt + (p4 >> 1)) ^ (r1 & 15)),
                    vb0 + r0 * 256 + 16 * ((2 * dt + 2 + (p4 >> 1)) ^ (r0 & 15)), vb0 + r1 * 256 + 16 * ((2 * dt + 2 + (p4 >> 1)) ^ (r1 & 15)));
                OT[dt] = __builtin_amdgcn_mfma_f32_16x16x32_bf16(__builtin_bit_cast(bf16x8, (u32x4){f00.x, f00.y, f01.x, f01.y}), bP, OT[dt], 0, 0, 0);
                OT[dt + 1] = __builtin_amdgcn_mfma_f32_16x16x32_bf16(__builtin_bit_cast(bf16x8, (u32x4){f10.x, f10.y, f11.x, f11.y}), bP, OT[dt + 1], 0, 0, 0);
            }
            SA_FENCE();
            { const bf16_t* const seln = selrow; const bf16_t* const vn_ = vbase;
              if (DB) { if (c + 2 < 8) { selrow = selcur; vbase = vcur; SA_ISSUE_V(c + 2, c & 1); selrow = seln; vbase = vn_; } else if (valid) SA_ISSUE_V(c - 6, c & 1); }
              else    { if (c + 1 < 8) { selrow = selcur; vbase = vcur; SA_ISSUE_V(c + 1, 0); selrow = seln; vbase = vn_; } else if (valid) SA_ISSUE_V(0, 0); } }
            SA_FENCE();
            if (c == 4 && valid) { SA_LOADK(0); SA_LOADK(1); SA_LOADK(2); SA_FENCE(); }
        }
        if (n < 4) {
#pragma unroll
            for (int dt = 0; dt < 8; ++dt) { u32x2 w; w.x = cvt_pk_bf16(OT[dt][0] * inv, OT[dt][1] * inv); w.y = cvt_pk_bf16(OT[dt][2] * inv, OT[dt][3] * inv); __builtin_nontemporal_store(w, (u32x2*)(qcur + n * 128 + 16 * dt + 4 * gq)); }
        }
        if (!valid) break;
        it = nxt;
    }
#undef SA_DECODE
#undef SA_ISSUE_V
#undef SA_LOAD_SKQ
#undef SA_LOADK
#undef SA_FENCE
}

#define SEL_DPP(v, ctrl, rowmask) ((unsigned)__builtin_amdgcn_update_dpp(0, (int)(v), (ctrl), (rowmask), 0xf, false))
__device__ __forceinline__ unsigned row_incl_scan(unsigned v) { v += SEL_DPP(v, 0x111, 0xf); v += SEL_DPP(v, 0x112, 0xf); v += SEL_DPP(v, 0x114, 0xf); v += SEL_DPP(v, 0x118, 0xf); return v; }
__device__ __forceinline__ unsigned wave_incl_scan(unsigned v) { v = row_incl_scan(v); v += SEL_DPP(v, 0x142, 0xa); v += SEL_DPP(v, 0x143, 0xc); return v; }
__device__ __forceinline__ unsigned row_min_all(unsigned v) { v = min(v, SEL_DPP(v, 0xB1, 0xf)); v = min(v, SEL_DPP(v, 0x4E, 0xf)); v = min(v, SEL_DPP(v, 0x141, 0xf)); v = min(v, SEL_DPP(v, 0x140, 0xf)); return v; }
__device__ __forceinline__ unsigned row_max_all(unsigned v) { v = max(v, SEL_DPP(v, 0xB1, 0xf)); v = max(v, SEL_DPP(v, 0x4E, 0xf)); v = max(v, SEL_DPP(v, 0x141, 0xf)); v = max(v, SEL_DPP(v, 0x140, 0xf)); return v; }
template <int FB> __device__ __forceinline__ unsigned sel_bin(unsigned d) { return ((d & ((1u << FB) - 1u)) << 6) | (d >> FB); }
template <int FB> __device__ __forceinline__ void sel_find_bin(const LAS unsigned* h, unsigned need, LAS unsigned* out, LAS unsigned* out2, LAS unsigned* tie, int lane) {
    const int rl = 63 - lane;
    unsigned c = 0;
#pragma unroll
    for (int k = 0; k < (1 << FB); ++k) c += h[k * 64 + rl];
    const unsigned incl = wave_incl_scan(c);
    const unsigned above = incl - c;
    const unsigned long long m = __ballot(above < need && need <= incl);
    if (m == 0ull) return;
    const int hl = __builtin_ctzll(m);
    const unsigned hg = (unsigned)(63 - hl);
    const unsigned need2 = need - (unsigned)__builtin_amdgcn_readlane((int)above, hl);
    const int fb = (1 << FB) - 1 - lane;
    const unsigned f = lane < (1 << FB) ? h[fb * 64 + hg] : 0u;
    const unsigned incl2 = wave_incl_scan(f);
    const unsigned above2 = incl2 - f;
    if (above2 < need2 && need2 <= incl2) { out[0] = (hg << FB) + (unsigned)fb; out[1] = need2 - above2; if (out2) *out2 = f; if (tie && f > need2 - above2) *tie = 1u; }
}
#define SEL_BIN(d) sel_bin<6>(d)
__device__ __forceinline__ void phase_dsa_select(KP p, LAS unsigned char* lds) {
    const int tid = tid_opaque(), lane0 = tid & 63, wid0 = __builtin_amdgcn_readfirstlane(tid >> 6);
    LAS unsigned* hist = (LAS unsigned*)lds;
    LAS unsigned short* cntG = (LAS unsigned short*)(lds + 65536);
    LAS unsigned short* cntE = cntG + 4096;
    LAS unsigned* ctl = (LAS unsigned*)(lds + 131072);
    const int xcd = blockIdx.x & 7, b = xcd >> 2, lb = (blockIdx.x >> 3) * 4 + (xcd & 3);
    const int nlb = (gridDim.x >> 3) * 4;
    for (int gi = lb; gi < SEQ / 4; gi += nlb) {
        const int t0 = 4 * gi; const size_t mq0 = (size_t)b * SEQ + t0;
        int lane = lane0, wid = wid0; asm volatile("" : "+v"(lane), "+s"(wid));
        const int n = lane & 15, gq = lane >> 4;
        if (t0 + 4 <= TOPK) {
            const int tidp = wid * 64 + lane; const int q = tidp >> 7, i = (tidp & 127) * 2, t = t0 + q;
            *(unsigned*)(p->sel + (mq0 + q) * TOPK + i) = (unsigned)(i <= t ? i : 0xFFFF) | ((unsigned)(i + 1 <= t ? i + 1 : 0xFFFF) << 16);
            continue;
        }
        const int NT = (t0 + 3) / 16 + 1;
        bf16x8 aq[2];
#pragma unroll
        for (int ks = 0; ks < 2; ++ks) aq[ks] = *(const bf16x8*)(p->qib + (mq0 + (n >> 2)) * 256 + (n & 3) * 64 + 32 * ks + 8 * gq);
        const f32x4 w4 = *(const f32x4*)(p->wi + (mq0 + gq) * 4);
        const int tq = t0 + gq;
        const int nj = (NT - wid + 7) >> 3;
        const int NB = (nj + 1) >> 1;
        LAS unsigned char* ring = lds + wid * 16384; const unsigned ring32 = lds_addr32(ring);
        const bf16_t* kib0 = p->kib + (size_t)b * SEQ * 64;
        const int dk = lane >> 3, dc = (lane & 7);
        const unsigned dvoff = (unsigned)(dk * 128 + 16 * (dc ^ (dk & 7)));
        const unsigned ringS = (unsigned)__builtin_amdgcn_readfirstlane((int)ring32);
#define SEL_ISSUE(blk) do { _Pragma("unroll") for (int _jj = 0; _jj < 2; ++_jj) { int _tile = 8 * (2 * (blk) + _jj) + wid; _tile = _tile < NT ? _tile : NT - 1; \
            glds16x2_s(kib0 + (size_t)_tile * 1024, dvoff, ringS + (((blk) & 3) * 2 + _jj) * 2048); } } while (0)
        unsigned mk[128];
        unsigned m1 = 0u, m2 = 0u;
        SEL_ISSUE(0); SEL_ISSUE(1); SEL_ISSUE(2);
        asm volatile("" :: "v"(aq[0]), "v"(aq[1]), "v"(w4));
        const unsigned ra0 = ring32 + n * 128 + 16 * (gq ^ (n & 7)), ra1 = ring32 + n * 128 + 16 * ((4 + gq) ^ (n & 7));
#pragma unroll
        for (int blk = 0; blk < 64; ++blk) {
            if (blk < NB) {
                SEL_ISSUE(blk + 3);
                asm volatile("s_waitcnt vmcnt(12)" ::: "memory");
#pragma unroll
                for (int jj = 0; jj < 2; ++jj) { const int tile = 8 * (2 * blk + jj) + wid;
                    u32x4 k0, k1; ds_read_b128_x2(k0, k1, ra0, ra1, ((blk & 3) * 2 + jj) * 2048);
                    f32x4 acc = __builtin_amdgcn_mfma_f32_16x16x32_bf16(aq[0], __builtin_bit_cast(bf16x8, k0), (f32x4){0.f, 0.f, 0.f, 0.f}, 0, 0, 0);
                    acc = __builtin_amdgcn_mfma_f32_16x16x32_bf16(aq[1], __builtin_bit_cast(bf16x8, k1), acc, 0, 0, 0);
                    float sc = w4[0] * relu_(acc[0]) + w4[1] * relu_(acc[1]) + w4[2] * relu_(acc[2]) + w4[3] * relu_(acc[3]);
                    sc += 0.0f;
                    const unsigned bits = __float_as_uint(sc); const unsigned mono = bits ^ ((bits >> 31) ? 0xFFFFFFFFu : 0x80000000u);
                    const unsigned kv = (16 * tile + n <= tq) ? mono : 0u; mk[2 * blk + jj] = kv; m2 = max(m2, min(m1, kv)); m1 = max(m1, kv); }
            } else { mk[2 * blk] = 0u; mk[2 * blk + 1] = 0u; }
        }
#undef SEL_ISSUE
        asm volatile("s_waitcnt vmcnt(0)" ::: "memory");
        __syncthreads();
        int lane_b = 16 * gq + n, wid_b = __builtin_amdgcn_readfirstlane(wid); asm volatile("" : "+v"(lane_b), "+s"(wid_b));
        const int tid_b = wid_b * 64 + lane_b;
        LAS unsigned* hq = hist + gq * 4096;
#define SEL_ZERO_HIST() do { const u32x4 z = (u32x4){0u, 0u, 0u, 0u}; _Pragma("unroll") for (int i = 0; i < 8; ++i) *(LAS u32x4*)(hist + (i * NTHREADS + tid_b) * 4) = z; } while (0)
        unsigned lbound;
        {
          m2 = row_min_all(m2); m1 = row_max_all(m1);
          if (n == 0) { ctl[8 + wid * 4 + gq] = m2; ctl[64 + wid * 4 + gq] = m1; }
          if (tid_b < 24) ctl[40 + tid_b] = 0u;
          { const u32x4 z = (u32x4){0u, 0u, 0u, 0u};
#pragma unroll
            for (int i = 0; i < 8; ++i) *(LAS u32x4*)(lds + 65536 + (i * NTHREADS + tid_b) * 16) = z;
            *(LAS u32x4*)(lds + 133632 + tid_b * 16) = z; }
          __syncthreads();
          unsigned lb2 = ctl[8 + gq];
#pragma unroll
          for (int w = 1; w < NWAVES; ++w) lb2 = min(lb2, ctl[8 + w * 4 + gq]);
          lbound = lb2; }
        constexpr int LCAP = 2048;
        LAS unsigned* lc = ctl + 40; LAS unsigned* tief = ctl + 48; LAS unsigned short* selt = (LAS unsigned short*)(lds + 131584);
        { const unsigned lb1 = max(lbound, 1u);
          unsigned cnt = 0u;
#pragma unroll
          for (int jb = 0; jb < 16; ++jb) { if (8 * jb < nj) {
#pragma unroll
              for (int jj = 0; jj < 8; ++jj) cnt += (mk[8 * jb + jj] >= lb1) ? 1u : 0u; } }
          const unsigned incl = row_incl_scan(cnt);
          unsigned base = 0u;
          if (n == 15) base = __hip_atomic_fetch_add(lc + gq, incl, __ATOMIC_RELAXED, __HIP_MEMORY_SCOPE_WORKGROUP);
          base = row_max_all(base);
          const unsigned lbw = (base + incl > (unsigned)LCAP) ? 0xFFFFFFFFu : lb1;
          LAS u32x2* wp = (LAS u32x2*)(lds + gq * (LCAP * 8)) + (base + incl - cnt);
#pragma unroll
          for (int jb = 0; jb < 16; ++jb) { if (8 * jb < nj) {
#pragma unroll
              for (int jj = 0; jj < 8; ++jj) { const int j = 8 * jb + jj; const unsigned v = mk[j];
                  if (v >= lbw) { unsigned vv = v; asm volatile("" : "+v"(vv));
                      *wp = (u32x2){vv, (unsigned)(16 * (8 * j + wid) + n)}; ++wp; } }
              asm volatile("" ::: "memory"); } } }
        __syncthreads();
        const bool overflow = (lc[0] > (unsigned)LCAP) || (lc[1] > (unsigned)LCAP) || (lc[2] > (unsigned)LCAP) || (lc[3] > (unsigned)LCAP);
        if (!overflow) {
            int lane_c = lane_b, wid_c = __builtin_amdgcn_readfirstlane(wid_b); asm volatile("" : "+v"(lane_c), "+s"(wid_c));
            const int q = wid_c >> 1, r = ((wid_c & 1) << 6) | lane_c; const unsigned nq = (unsigned)__builtin_amdgcn_readfirstlane((int)lc[q]);
            LAS unsigned* ha = (LAS unsigned*)(lds + 65536) + q * 2048; LAS unsigned* hb = (LAS unsigned*)(lds + 98304) + q * 2048;
            u32x2 ent[16];
            const bool big = nq > 1024u;
#define SEL_FOR_ENT(...) do { _Pragma("unroll") for (int i = 0; i < 8; ++i) { __VA_ARGS__ } if (big) { _Pragma("unroll") for (int i = 8; i < 16; ++i) { __VA_ARGS__ } } } while (0)
            { const LAS unsigned char* lq = lds + q * (LCAP * 8);
#pragma unroll
              for (int i = 8; i < 16; ++i) ent[i] = (u32x2){0u, 0u};
              SEL_FOR_ENT(const u32x2 t = *(const LAS u32x2*)(lq + (128 * i + r) * 8); ent[i].x = ((unsigned)(128 * i + r) < nq) ? t.x : 0u; ent[i].y = t.y;); }
            unsigned lbq = ctl[8 + q], vmax = ctl[64 + q];
#pragma unroll
            for (int w = 1; w < NWAVES; ++w) { lbq = min(lbq, ctl[8 + w * 4 + q]); vmax = max(vmax, ctl[64 + w * 4 + q]); }
            lbq = max(lbq, 1u) - 1u;
            SEL_FOR_ENT(ent[i].x = (ent[i].x != 0u) ? ent[i].x - lbq : 0u;);
            const int nbits = 32 - __builtin_clz(vmax - lbq);
            const int s0 = max(nbits - 11, 0), s1 = max(s0 - 11, 0);
            unsigned pref = 0u, need = (unsigned)TOPK;
            SEL_FOR_ENT(const unsigned v = ent[i].x; if (v != 0u) __hip_atomic_fetch_add(ha + sel_bin<5>(v >> s0), 1u, __ATOMIC_RELAXED, __HIP_MEMORY_SCOPE_WORKGROUP););
            __syncthreads();
            if ((wid & 1) == 0) sel_find_bin<5>(ha, need, ctl + 2 * q, ctl + 52 + q, (LAS unsigned*)nullptr, lane);
            __syncthreads();
            pref = ctl[2 * q]; need = ctl[2 * q + 1];
#pragma unroll
            for (int k = 0; k < 4; ++k) *(LAS u32x4*)(ha + (k * 128 + r) * 4) = (u32x4){0u, 0u, 0u, 0u};
            SEL_FOR_ENT(const unsigned v = ent[i].x; if (v != 0u && (v >> s0) == pref) __hip_atomic_fetch_add(hb + sel_bin<5>((v >> s1) & ((1u << (s0 - s1)) - 1u)), 1u, __ATOMIC_RELAXED, __HIP_MEMORY_SCOPE_WORKGROUP););
            __syncthreads();
            if ((wid & 1) == 0) sel_find_bin<5>(hb, need, ctl + 2 * q, ctl + 52 + q, (LAS unsigned*)nullptr, lane);
            __syncthreads();
            pref = (pref << (s0 - s1)) | ctl[2 * q]; need = ctl[2 * q + 1];
            SEL_FOR_ENT(const unsigned v = ent[i].x; if (v != 0u && (v >> s1) == pref) __hip_atomic_fetch_add(ha + sel_bin<4>(v & ((1u << s1) - 1u)), 1u, __ATOMIC_RELAXED, __HIP_MEMORY_SCOPE_WORKGROUP););
            __syncthreads();
            if ((wid & 1) == 0) sel_find_bin<4>(ha, need, ctl + 2 * q, ctl + 52 + q, tief, lane);
            __syncthreads();
            pref = (pref << s1) | ctl[2 * q]; need = ctl[2 * q + 1];
            const unsigned tau = pref, needE = need, nE = ctl[52 + q];
            unsigned thrR = 0u;
            if (*tief) {
                unsigned prefR = 0u, needR = needE;
#pragma unroll
                for (int lvl = 0; lvl < 2; ++lvl) {
                    if (r < 32) *(LAS u32x4*)(ha + r * 4) = (u32x4){0u, 0u, 0u, 0u};
                    __syncthreads();
                    SEL_FOR_ENT(if (ent[i].x == tau) { const unsigned kr = 16383u - ent[i].y;
                        if (lvl == 0 || (kr >> 7) == prefR) __hip_atomic_fetch_add(ha + sel_bin<1>(lvl == 0 ? (kr >> 7) : (kr & 127u)), 1u, __ATOMIC_RELAXED, __HIP_MEMORY_SCOPE_WORKGROUP); });
                    __syncthreads();
                    if ((wid & 1) == 0) sel_find_bin<1>(ha, needR, ctl + 2 * q, (LAS unsigned*)nullptr, (LAS unsigned*)nullptr, lane);
                    __syncthreads();
                    prefR = (prefR << 7) | ctl[2 * q]; needR = ctl[2 * q + 1];
                }
                thrR = (nE > needE) ? prefR : 0u;
            }
            LAS unsigned* bm = (LAS unsigned*)(lds + 133632) + q * 512;
            SEL_FOR_ENT(const unsigned v = ent[i].x; const unsigned ix = ent[i].y;
                if (v > tau || (v == tau && (16383u - ix) >= thrR)) __hip_atomic_fetch_or(bm + (ix >> 5), 1u << (ix & 31u), __ATOMIC_RELAXED, __HIP_MEMORY_SCOPE_WORKGROUP););
            __syncthreads();
            { const u32x4 w = *(const LAS u32x4*)(bm + 4 * r);
              const unsigned c = (unsigned)(__popc(w.x) + __popc(w.y) + __popc(w.z) + __popc(w.w));
              const unsigned incl = wave_incl_scan(c);
              if (lane_c == 63) ctl[56 + wid_c] = incl;
              __syncthreads();
              unsigned pos = incl - c + ((wid_c & 1) ? ctl[56 + wid_c - 1] : 0u);
              LAS unsigned short* st = selt + q * TOPK;
#pragma unroll
              for (int k = 0; k < 4; ++k) { unsigned ww = w[k];
                  while (ww) { const unsigned bpos = (unsigned)__builtin_ctz(ww); if (pos < (unsigned)TOPK) st[pos] = (unsigned short)(128 * r + 32 * k + bpos); ++pos; ww &= ww - 1u; } }
              __syncthreads();
              *(unsigned*)(p->sel + (mq0 + q) * TOPK + 2 * r) = *(const LAS unsigned*)(st + 2 * r); }
#undef SEL_FOR_ENT
            continue;
        }
        SEL_ZERO_HIST();
        __syncthreads();
        unsigned pref = 0u, need = (unsigned)TOPK;
#pragma unroll
        for (int lvl = 0; lvl < 3; ++lvl) {
            const int sh = lvl == 0 ? 20 : (lvl == 1 ? 8 : 0), nb = lvl == 2 ? 8 : 12;
            if (lvl > 0) { __syncthreads(); SEL_ZERO_HIST(); __syncthreads(); }
#pragma unroll
            for (int jb = 0; jb < 16; ++jb) { if (8 * jb < nj) {
#pragma unroll
                for (int jj = 0; jj < 8; ++jj) { const unsigned v = mk[8 * jb + jj];
                    const bool in = (lvl == 0) ? (v != 0u && v >= lbound) : ((v >> (sh + nb)) == pref);
                    if (in) { const unsigned d = (v >> sh) & ((1u << nb) - 1u); __hip_atomic_fetch_add(hq + SEL_BIN(d), 1u, __ATOMIC_RELAXED, __HIP_MEMORY_SCOPE_WORKGROUP); } }
                asm volatile("" ::: "memory"); } }
            __syncthreads();
            if (wid < 4) { const unsigned nq = (unsigned)__builtin_amdgcn_readlane((int)need, 16 * wid);
                sel_find_bin<6>(hist + wid * 4096, nq, ctl + 2 * wid, (LAS unsigned*)nullptr, (LAS unsigned*)nullptr, lane); }
            __syncthreads();
            pref = (pref << nb) | ctl[2 * gq]; need = ctl[2 * gq + 1];
        }
#undef SEL_ZERO_HIST
        const unsigned tau = pref, needE = need;
        { const u32x4 z = (u32x4){0u, 0u, 0u, 0u}; *(LAS u32x4*)(cntG + tid_b * 8) = z; *(LAS u32x4*)(cntG + 4096 + tid_b * 8) = z; }
        __syncthreads();
#pragma unroll
        for (int jb = 0; jb < 16; ++jb) { if (8 * jb < nj) {
#pragma unroll
            for (int jj = 0; jj < 8; ++jj) { const int j = 8 * jb + jj; const unsigned v = mk[j];
                const unsigned long long bg = __ballot(v > tau), be = __ballot(v == tau);
                if ((bg | be) && n == 0) { const int tile = 8 * j + wid; cntG[gq * 1024 + tile] = (unsigned short)__popc((unsigned)(bg >> (16 * gq)) & 0xffffu); cntE[gq * 1024 + tile] = (unsigned short)__popc((unsigned)(be >> (16 * gq)) & 0xffffu); } }
            asm volatile("" ::: "memory"); } }
        __syncthreads();
        { LAS unsigned short* cp = (wid < 4 ? cntG : cntE) + (wid & 3) * 1024 + 16 * lane;
          const u32x4 a = *(const LAS u32x4*)cp, c2 = *(const LAS u32x4*)(cp + 8);
          unsigned v[16] = {a.x & 0xffffu, a.x >> 16, a.y & 0xffffu, a.y >> 16, a.z & 0xffffu, a.z >> 16, a.w & 0xffffu, a.w >> 16, c2.x & 0xffffu, c2.x >> 16, c2.y & 0xffffu, c2.y >> 16, c2.z & 0xffffu, c2.z >> 16, c2.w & 0xffffu, c2.w >> 16};
          unsigned tot = 0;
#pragma unroll
          for (int i = 0; i < 16; ++i) { const unsigned t = v[i]; v[i] = tot; tot += t; }
          const unsigned incl = wave_incl_scan(tot);
          const unsigned base = incl - tot;
          u32x4 o0, o1;
          o0.x = (v[0] + base) | ((v[1] + base) << 16); o0.y = (v[2] + base) | ((v[3] + base) << 16); o0.z = (v[4] + base) | ((v[5] + base) << 16); o0.w = (v[6] + base) | ((v[7] + base) << 16);
          o1.x = (v[8] + base) | ((v[9] + base) << 16); o1.y = (v[10] + base) | ((v[11] + base) << 16); o1.z = (v[12] + base) | ((v[13] + base) << 16); o1.w = (v[14] + base) | ((v[15] + base) << 16);
          *(LAS u32x4*)cp = o0; *(LAS u32x4*)(cp + 8) = o1; }
        __syncthreads();
        { unsigned tau2 = tau; asm volatile("" : "+v"(tau2));
          bf16_t* so = p->sel + (mq0 + gq) * TOPK; const unsigned below = (1u << n) - 1u; const unsigned cG = (unsigned)TOPK - needE;
#pragma unroll
          for (int jb = 0; jb < 16; ++jb) { if (8 * jb < nj) {
#pragma unroll
              for (int jj = 0; jj < 8; ++jj) { const int j = 8 * jb + jj; const unsigned v = mk[j];
                  const bool isg = v > tau2, ise = v == tau2;
                  const unsigned long long bg = __ballot(isg), be = __ballot(ise);
                  if (bg | be) { const int tile = 8 * j + wid;
                      const unsigned mg = (unsigned)(bg >> (16 * gq)) & 0xffffu, me = (unsigned)(be >> (16 * gq)) & 0xffffu;
                      if (isg) { const unsigned slot = cntG[gq * 1024 + tile] + __popc(mg & below); so[slot] = (bf16_t)(16 * tile + n); }
                      else if (ise) { const unsigned rank = cntE[gq * 1024 + tile] + __popc(me & below); if (rank < needE) so[cG + rank] = (bf16_t)(16 * tile + n); } } }
              asm volatile("" ::: "memory"); } } }
        __syncthreads();
    }
}

enum { PH_PRO = 0, PH_XKV, PH_INPROJ, PH_SELECT, PH_MIX, PH_FINISH, PH_GATES, PH_OUT, PH_NORM1, PH_XQ, PH_XS, PH_XSM, PH_XPV, PH_XO, PH_NORM2, PH_GU, PH_DOWN, PH_NORM3, PH_COUNT };

template <int ONLY>
__device__ __forceinline__ void layer_body(KP p, const int l, LAS unsigned char* lds, const XcdBarrier& bar) {
#define RUN(ph) (ONLY < 0 || ONLY == (ph))
#define SYNC() do { if (ONLY < 0) xcd_barrier(bar); } while (0)
    StaticOrder so;

        const bf16_t* wl = p->wt + (size_t)l * WT_LAYER;
        const float* xin = (l == 0) ? p->x : p->out;
        bf16_t* RQ = p->raw; bf16_t* RK = p->raw + (size_t)MTOK * 1024; bf16_t* RV = p->raw + (size_t)MTOK * 2048;
        if (RUN(PH_INPROJ)) { Gemm g = pg8::make_gemm(p->xn, wl + WT_IN, MTOK, 5120, 1024); so.init(MTOK, 5120, gridDim.x, blockIdx.x); pg8::gemm_phase(lds, g, so, EpiInProj{p, l}); }
        SYNC();
        if (RUN(PH_SELECT)) { phase_gdn_prep(p, l, lds); __syncthreads(); phase_dsa_select(p, lds); }
        SYNC();
        if (RUN(PH_MIX)) {
            const int tid_ = tid_opaque(); const int wid_ = __builtin_amdgcn_readfirstlane(tid_ >> 6), lane_ = tid_ & 63;
            volatile LAS unsigned* sflag = (volatile LAS unsigned*)(lds + LDS_BYTES - 48);
            volatile LAS unsigned* f_dma = (volatile LAS unsigned*)(lds + LDS_BYTES - 64); volatile LAS unsigned* f_vr = f_dma + 1; volatile LAS unsigned* f_done = f_dma + 2;
            const unsigned fbase = 256u * (unsigned)l;
            const unsigned qx_ = blockIdx.x & 63u; unsigned* ctr = p->bar + XCD_BAR_WORDS + 64 + 24576 + (l * 64 + (int)qx_) * 16;
            if (blockIdx.x < 128) {
                if (wid_ == 0) { __builtin_amdgcn_s_setprio(1); gdn_scan_unit(p, blockIdx.x, lds, lane_, f_vr, f_done, fbase); __builtin_amdgcn_s_setprio(0);
                    asm volatile("s_waitcnt vmcnt(0) lgkmcnt(0)" ::: "memory"); *sflag = (unsigned)(l + 1); }
                else if (wid_ <= 5) phase_sparse_attn<false>(p, ctr, qx_, lds + SC_END + (wid_ - 1) * 8192, lane_);
                else { if (wid_ == 6) gdn_scan_issuer(p, l, blockIdx.x, lds, lane_, f_dma, f_done, fbase); else gdn_scan_conv(p, l, blockIdx.x, lds, lane_, f_dma, f_vr, f_done, fbase);
                    { unsigned sp_ = 0; while (*sflag < (unsigned)(l + 1) && ++sp_ < SC_SPIN_CAP) __builtin_amdgcn_s_sleep(32); }
                    phase_sparse_attn<true>(p, ctr, qx_, lds + (wid_ - 5) * SA_LDS_WAVE, lane_); }
            } else phase_sparse_attn<true>(p, ctr, qx_, lds + wid_ * SA_LDS_WAVE, lane_);
        }
        SYNC();
        if (RUN(PH_GATES)) { Gemm g = pg8::make_gemm(p->xn, wl + WT_GATE, MTOK, 2048, 1024); so.init(MTOK, 2048, gridDim.x, blockIdx.x); pg8::gemm_phase(lds, g, so, EpiGates{RQ, p->qb, RV, p->gdn_norm + l * 128, lds + 131072}); }
        if (l == 0 && RUN(PH_XKV)) {
            Gemm g = pg8::make_gemm(p->memn, p->wt + WT_XKV, 1024, 2048, 1024); g.bat_div = 2; g.b_bat = WT_LAYER;
            so.init(1024, 2048, gridDim.x, blockIdx.x); pg8::gemm_phase(lds, g, so, EpiXKV{p->xk, p->xvt});
        }
        SYNC();
        if (RUN(PH_OUT)) { Gemm g = pg8::make_gemm(RQ, wl + WT_OUT, MTOK, 1024, 1024); so.init(MTOK, 1024, gridDim.x, blockIdx.x);
            pg8::gemm_phase(lds, g, so, EpiNormFused{xin, p->out, p->xn, p->norm_mix_post + l * 1024, p->norm_x_pre + l * 1024, p->npart, p->bar + XCD_BAR_WORDS + 64 + ((l * 3 + 0) * 2) * 128 * 16, lds + 131072}); }
        SYNC();
        if (RUN(PH_XQ)) { Gemm g = pg8::make_gemm(p->xn, wl + WT_XQ, MTOK, 1024, 1024); so.init(MTOK, 1024, gridDim.x, blockIdx.x); pg8::gemm_phase(lds, g, so, EpiPlain{p->qb, 1024, 0.0625f}); }
        if (ONLY < 0) __syncthreads();
        if (RUN(PH_XS)) {
            Gemm g = pg8::make_gemm(p->qb, p->xk + (size_t)l * 512 * 1024, MTOK, 1024, 256); g.lda = 1024; g.ldb = 1024; g.a_pn = 256; g.b_pn = 256; g.bat_div = 64; g.b_bat = 256l * 1024;
            so.init(MTOK, 1024, gridDim.x, blockIdx.x); pg8::gemm_phase(lds, g, so, EpiSoftmaxP{RV, lds + 131072});
        }
        if (ONLY < 0) __syncthreads();
        if (RUN(PH_XPV)) {
            Gemm g = pg8::make_gemm(RV, p->xvt + (size_t)l * 2 * 4 * 65536, MTOK, 1024, 256); g.lda = 1024; g.ldb = 256; g.a_pn = 256; g.b_pn = 65536; g.bat_div = 64; g.b_bat = 4l * 65536;
            so.init(MTOK, 1024, gridDim.x, blockIdx.x); pg8::gemm_phase(lds, g, so, EpiPlain{p->xn, 1024, 1.0f});
        }
        SYNC();
        if (RUN(PH_XO)) { Gemm g = pg8::make_gemm(p->xn, wl + WT_XO, MTOK, 1024, 1024); so.init(MTOK, 1024, gridDim.x, blockIdx.x);
            pg8::gemm_phase(lds, g, so, EpiNormFused{p->out, p->out, p->xn, p->norm_x_post + l * 1024, p->norm_ffn_pre + l * 1024, p->npart, p->bar + XCD_BAR_WORDS + 64 + ((l * 3 + 1) * 2) * 128 * 16, lds + 131072}); }
        SYNC();
        if (RUN(PH_GU)) { Gemm g = pg8::make_gemm(p->xn, wl + WT_GU, MTOK, 5632, 1024); so.init(MTOK, 5632, gridDim.x, blockIdx.x); pg8::gemm_phase(lds, g, so, EpiSwiGLU{p->raw}); }
        SYNC();
        if (RUN(PH_DOWN)) { Gemm g = pg8::make_gemm(p->raw, wl + WT_DOWN, MTOK, 1024, 2816); so.init(MTOK, 1024, gridDim.x, blockIdx.x);
            pg8::gemm_phase(lds, g, so, EpiNormFused{p->out, p->out, p->xn, p->norm_ffn_post + l * 1024, (l + 1 < DEPTH) ? p->norm_mix_pre + (l + 1) * 1024 : nullptr, p->npart, p->bar + XCD_BAR_WORDS + 64 + ((l * 3 + 2) * 2) * 128 * 16, lds + 131072}); }
        SYNC();

#undef RUN
#undef SYNC
}

template <int ONLY>
__global__ void __launch_bounds__(NTHREADS, 2) fwd_kernel(Params p_unused, int layer_only) {
    KP p = (KP)__builtin_amdgcn_kernarg_segment_ptr();
    extern __shared__ __attribute__((aligned(16))) unsigned char shm[];
    LAS unsigned char* lds = (LAS unsigned char*)shm;
    volatile LAS unsigned* xbw = (volatile LAS unsigned*)(lds + LDS_BYTES - 16);
    XcdBarrier bar;
    if (ONLY < 0) {
        if (threadIdx.x == 0) { xbw[0] = 0u; xbw[1] = 0u; xbw[2] = 0u; xbw[3] = 0u; xbw[-8] = 0u; xbw[-12] = 0u; xbw[-11] = 0u; xbw[-10] = 0u; }
        __syncthreads();
        bar = xcd_barrier_post(p->bar, xbw);
    }
#define RUN(ph) (ONLY < 0 || ONLY == (ph))
#define SYNC() do { if (ONLY < 0) xcd_barrier(bar); } while (0)
    StaticOrder so;
    if (RUN(PH_PRO)) { phase_prologue(p, lds); }
    SYNC();
    if (ONLY < 0) { layer_body<ONLY>(p, 0, lds, bar); layer_body<ONLY>(p, 1, lds, bar); } else { layer_body<ONLY>(p, layer_only, lds, bar); }
#undef RUN
#undef SYNC
}

static inline size_t align_up(size_t v, size_t a) { return (v + a - 1) / a * a; }

extern "C" void kernel_launch(void* const* d_in, const int* in_sizes, int n_in, void* d_out, int out_size, void* d_ws, size_t ws_size, hipStream_t stream) {
    (void)in_sizes; (void)n_in; (void)out_size;
    Params p;
    memset(&p, 0, sizeof(p));
    p.x = (const float*)d_in[0]; p.mem = (const float*)d_in[1]; p.positions = (const int*)d_in[2];
    p.norm_mix_pre = (const float*)d_in[3]; p.w_in = (const float*)d_in[4]; p.conv_w = (const float*)d_in[5]; p.a_log = (const float*)d_in[6]; p.dt_bias = (const float*)d_in[7];
    p.gdn_norm = (const float*)d_in[8]; p.w_out = (const float*)d_in[9]; p.norm_mix_post = (const float*)d_in[10]; p.norm_x_pre = (const float*)d_in[11]; p.norm_mem = (const float*)d_in[12];
    p.w_xq = (const float*)d_in[13]; p.w_xkv = (const float*)d_in[14]; p.w_xo = (const float*)d_in[15]; p.norm_x_post = (const float*)d_in[16]; p.norm_ffn_pre = (const float*)d_in[17];
    p.w_gu = (const float*)d_in[18]; p.w_down = (const float*)d_in[19]; p.norm_ffn_post = (const float*)d_in[20];
    p.out = (float*)d_out;
    char* w = (char*)d_ws; size_t off = 0;
    auto take = [&](size_t bytes) { char* r = w + off; off = align_up(off + bytes, 256); return r; };
    p.bar = (unsigned*)take((XCD_BAR_WORDS + 64 + 24576 + 2048) * 4);
    constexpr size_t TA_BYTES = (size_t)4096 * 8192 * 2, TA_DEAD = (size_t)2 * 512 * 1024 * 2 + (size_t)2 * MTOK * 64 * 4 + (size_t)WT_LAYER * 2;
    static_assert(TA_DEAD < TA_BYTES && (TA_BYTES - TA_DEAD) % 256 == 0 && ((size_t)WT_LAYER * 2) % 256 == 0, "overlay arithmetic");
    p.ta = (bf16_t*)take(TA_BYTES - TA_DEAD);
    p.memn = (bf16_t*)take((size_t)2 * 512 * 1024 * 2);
    p.rope_cos = (float*)take((size_t)MTOK * 64 * 4); p.rope_sin = (float*)take((size_t)MTOK * 64 * 4);
    p.wt = (bf16_t*)take((size_t)2 * WT_LAYER * 2);
    p.xk = (bf16_t*)take((size_t)2 * 512 * 1024 * 2); p.xvt = (bf16_t*)take((size_t)2 * 2 * 4 * 65536 * 2);
    p.xn = (bf16_t*)take((size_t)MTOK * 1024 * 2); p.qb = (bf16_t*)take((size_t)MTOK * 1024 * 2);
    p.kb = (bf16_t*)take((size_t)MTOK * 256 * 2); p.vb = (bf16_t*)take((size_t)MTOK * 256 * 2); p.qib = (bf16_t*)take((size_t)MTOK * 256 * 2); p.kib = (bf16_t*)take((size_t)MTOK * 64 * 2);
    p.wi = (float*)take((size_t)MTOK * 4 * 4); p.gg = (float*)take((size_t)MTOK * 8 * 4); p.beta = (float*)take((size_t)MTOK * 8 * 4);
    p.raw = (bf16_t*)take((size_t)MTOK * 3072 * 2); p.sel = (bf16_t*)take((size_t)MTOK * TOPK * 2);
    p.halo = (bf16_t*)take((size_t)(MTOK / 64) * 3 * 2048 * 2);
    p.npart = (float*)take((size_t)2 * MTOK * 4 * 4);
    if ((size_t)((char*)(p.wt + WT_LAYER) - (char*)p.ta) < TA_BYTES) { fprintf(stderr, "kernel_launch: overlay span too short\n"); return; }
    if (off > ws_size) { fprintf(stderr, "kernel_launch: workspace too small: need %zu have %zu\n", off, ws_size); return; }

    static int grid = 0;
    if (!grid) {
        int dev = 0, cus = 0, per_cu = 0;
        (void)hipGetDevice(&dev); (void)hipDeviceGetAttribute(&cus, hipDeviceAttributeMultiprocessorCount, dev);
        if (hipFuncSetAttribute((const void*)fwd_kernel<-1>, hipFuncAttributeMaxDynamicSharedMemorySize, LDS_BYTES) != hipSuccess) { fprintf(stderr, "kernel_launch: hipFuncSetAttribute failed\n"); grid = -1; return; }
        if (hipOccupancyMaxActiveBlocksPerMultiprocessor(&per_cu, (const void*)fwd_kernel<-1>, NTHREADS, LDS_BYTES) != hipSuccess || per_cu < 1) fprintf(stderr, "kernel_launch: occupancy query reports %d\n", per_cu);
        grid = cus > 0 ? cus : 256;
        if (grid > 256) grid = 256;
    }
    if (grid <= 0) return;
    (void)hipMemsetAsync(p.bar, 0, (XCD_BAR_WORDS + 64 + 24576 + 2048) * sizeof(unsigned), stream);
    hipLaunchKernelGGL(fwd_kernel<-1>, dim3(grid), dim3(NTHREADS), LDS_BYTES, stream, p, 0);
}
```

```cpp
#include <hip/hip_runtime.h>
#include <stdint.h>
#include <stdio.h>
#include <math.h>
#include <string.h>

#define LAS __attribute__((address_space(3)))
typedef unsigned short bf16_t;
typedef short bf16x8 __attribute__((ext_vector_type(8)));
typedef float f32x4 __attribute__((ext_vector_type(4)));
typedef float f32x2 __attribute__((ext_vector_type(2)));
typedef unsigned u32x4 __attribute__((ext_vector_type(4)));
typedef unsigned u32x2 __attribute__((ext_vector_type(2)));

constexpr int D_MODEL = 1024, BATCH = 2, SEQ = 16384, DEPTH = 2, MTOK = BATCH * SEQ;
constexpr int N_MEM = 256, FF = 2816, IN_COLS = 6996, TOPK = 256;
constexpr int OFF_AQ = 0, OFF_AK = 1024, OFF_AV = 1280, OFF_IQ = 1536, OFF_IK = 1792, OFF_IW = 1856, OFF_BQKV = 1860, OFF_BA = 4932, OFF_BB = 4940, OFF_GA = 4948, OFF_GB = 5972;
constexpr float EPS = 1e-6f;
constexpr int NTHREADS = 512, NWAVES = 8;
constexpr int LDS_BYTES = 151552;
constexpr int LDS_SCRATCH = 131072;

typedef __bf16 bf16x2_t __attribute__((ext_vector_type(2)));
__device__ __forceinline__ unsigned cvt_pk_bf16(float lo, float hi) { const f32x2 v = {lo, hi}; const bf16x2_t r = __builtin_convertvector(v, bf16x2_t); return __builtin_bit_cast(unsigned, r); }
__device__ __forceinline__ bf16_t f2bf(float x) { return (bf16_t)(cvt_pk_bf16(x, 0.f) & 0xffffu); }
__device__ __forceinline__ float bf2f(bf16_t x) { return __uint_as_float(((unsigned)x) << 16); }
__device__ __forceinline__ float bflo(unsigned w) { return __uint_as_float(w << 16); }
__device__ __forceinline__ float bfhi(unsigned w) { return __uint_as_float(w & 0xffff0000u); }
__device__ __forceinline__ float relu_(float x) { return __int_as_float(max(__float_as_int(x), 0)); }
__device__ __forceinline__ float sigmoidf_(float x) { return __builtin_amdgcn_rcpf(1.0f + __expf(-x)); }
__device__ __forceinline__ int tid_opaque() { int t = threadIdx.x; asm volatile("" : "+v"(t)); return t; }
#define WS_DPP(v, ctrl, rowmask) __int_as_float(__builtin_amdgcn_update_dpp(0, __float_as_int(v), (ctrl), (rowmask), 0xf, false))
__device__ __forceinline__ float wave_sum(float v) {
    v += WS_DPP(v, 0x111, 0xf); v += WS_DPP(v, 0x112, 0xf); v += WS_DPP(v, 0x114, 0xf); v += WS_DPP(v, 0x118, 0xf);
    v += WS_DPP(v, 0x142, 0xa); v += WS_DPP(v, 0x143, 0xc);
    return __int_as_float(__builtin_amdgcn_readlane(__float_as_int(v), 63));
}
__device__ __forceinline__ float wave_max(float v) {
#pragma unroll
    for (int o = 32; o > 0; o >>= 1) v = fmaxf(v, __shfl_xor(v, o));
    return v;
}

#define XB_TMO      128
#define XB_XCNT(j)  (256  + 64 * (j))
#define XB_XSUB(j)  (1280 + 64 * (j))
#define XB_XGEN(j)  (2304 + 64 * (j))
#define XB_TOP      3328
#define XB_TOPGEN   3392
#define XCD_BAR_WORDS 3456
#define XB_SPIN_CAP (1u << 25)

__device__ __forceinline__ unsigned xb_ld(unsigned* p)              { return __hip_atomic_load(p, __ATOMIC_RELAXED, __HIP_MEMORY_SCOPE_AGENT); }
__device__ __forceinline__ unsigned xb_add(unsigned* p, unsigned v) { return __hip_atomic_fetch_add(p, v, __ATOMIC_RELAXED, __HIP_MEMORY_SCOPE_AGENT); }
__device__ __forceinline__ unsigned xb_xcc_id() { return (unsigned)__builtin_amdgcn_s_getreg((3 << 11) | 20) & 0xFu; }
#define XB_SPIN(cond, bar) do { unsigned _sp = 0; while (cond) { __builtin_amdgcn_s_sleep(1); \
    if ((++_sp & 255u) == 0u) { if (xb_ld(&(bar)[XB_TMO])) break; if (_sp > XB_SPIN_CAP) { atomicAdd(&(bar)[XB_TMO], 1u); break; } } } } while (0)

struct XcdBarrier { unsigned* bar; unsigned x; volatile LAS unsigned* st; };

__device__ __forceinline__ XcdBarrier xcd_barrier_post(unsigned* bar, volatile LAS unsigned* st) {
    XcdBarrier b; b.bar = bar; b.x = xb_xcc_id(); b.st = st;
    if (threadIdx.x == 0) (void)xb_add(&bar[XB_XCNT(b.x)], 1u);
    return b;
}
__device__ __forceinline__ void xcd_barrier_complete(unsigned* bar, unsigned x, unsigned& nloc, unsigned& nx) {
    const unsigned G = gridDim.x * gridDim.y * gridDim.z;
    unsigned sum, cnt, mine, sp = 0u;
    for (;;) {
        sum = 0u; cnt = 0u; mine = 0u;
#pragma unroll
        for (unsigned j = 0; j < 16; ++j) { const unsigned c = xb_ld(&bar[XB_XCNT(j)]); sum += c; cnt += (c > 0u) ? 1u : 0u; mine = (j == x) ? c : mine; }
        if (sum == G) break;
        __builtin_amdgcn_s_sleep(1);
        if ((++sp & 255u) == 0u) { if (xb_ld(&bar[XB_TMO])) break; if (sp > XB_SPIN_CAP) { atomicAdd(&bar[XB_TMO], 1u); break; } }
    }
    nloc = mine > 0u ? mine : 1u; nx = cnt > 0u ? cnt : 1u;
}
__device__ __forceinline__ void xcd_barrier(const XcdBarrier& b) {
    asm volatile("s_waitcnt vmcnt(0)" ::: "memory");
    __syncthreads();
    if (threadIdx.x == 0) {
        unsigned* bar = b.bar;
        __builtin_amdgcn_s_waitcnt(0);
        unsigned nloc = b.st[0], nx = b.st[1];
        if (nloc == 0u) { xcd_barrier_complete(bar, b.x, nloc, nx); b.st[0] = nloc; b.st[1] = nx; }
        const unsigned old = xb_add(&bar[XB_XSUB(b.x)], 1u);
        const unsigned gen = old / nloc;
        if (old + 1u == (gen + 1u) * nloc) {
            __builtin_amdgcn_fence(__ATOMIC_RELEASE, "agent");
            asm volatile("s_waitcnt vmcnt(0)" ::: "memory");
            const unsigned og = xb_add(&bar[XB_TOP], 1u);
            const unsigned tg = og / nx;
            if (og + 1u == (tg + 1u) * nx) xb_add(&bar[XB_TOPGEN], 1u);
            else XB_SPIN(xb_ld(&bar[XB_TOPGEN]) == tg, bar);
            __builtin_amdgcn_fence(__ATOMIC_ACQUIRE, "agent");
            xb_add(&bar[XB_XGEN(b.x)], 1u);
            asm volatile("s_waitcnt vmcnt(0)" ::: "memory");
        } else {
            XB_SPIN(xb_ld(&bar[XB_XGEN(b.x)]) == gen, bar);
            __builtin_amdgcn_fence(__ATOMIC_ACQUIRE, "agent");
            asm volatile("s_waitcnt vmcnt(0)" ::: "memory");
        }
    }
    __syncthreads();
}

namespace pg8 {
constexpr int BM = 256, BK = 64, HALF = 128, HTB = HALF * BK * 2, STAGE_BYTES = 8 * HTB, NXCD = 8, WGM = 8;
__host__ __device__ __forceinline__ int lds_byte(int r, int c) { const int st = (r >> 4) * 2 + (c >> 5), rr = r & 15, cc = c & 31, ob = rr * 64 + cc * 2; return st * 1024 + (ob ^ (((ob >> 9) & 1) << 5)); }
__host__ __device__ __forceinline__ void stage_rc(int b, int& R, int& C) { const int st = b / 1024, sb = b % 1024, swz = sb ^ (((sb >> 9) & 1) << 5); R = (st >> 1) * 16 + swz / 64; C = (st & 1) * 32 + (swz % 64) / 2; }
struct Unit { int pm, pn; };
struct Gemm {
    const bf16_t* A; const bf16_t* Bt; int lda, ldb, K, M, N; long a_pn, b_pn; int bat_div; long b_bat;
    __device__ __forceinline__ const char* abase(const Unit& u) const { return (const char*)(A + (long)u.pm * BM * lda + (long)u.pn * a_pn); }
    __device__ __forceinline__ const char* bbase(const Unit& u) const { return (const char*)(Bt + (long)u.pn * b_pn + (bat_div ? (long)(u.pm / bat_div) * b_bat : 0l)); }
};
__host__ __device__ inline Gemm make_gemm(const bf16_t* A, const bf16_t* Bt, int M, int N, int K) { Gemm g; g.A = A; g.Bt = Bt; g.lda = K; g.ldb = K; g.K = K; g.M = M; g.N = N; g.a_pn = 0; g.b_pn = (long)BM * K; g.bat_div = 0; g.b_bat = 0; return g; }

struct StaticOrder {
    int nM, nN, nwg, G, c;
    __host__ __device__ void init(int M, int N, int G_, int c_) { nM = M / BM; nN = N / BM; nwg = nM * nN; G = G_; c = c_; }
    __host__ __device__ bool next(int i, Unit& u) const {
        const long L = (long)i * G + c; if (L >= nwg) return false;
        int wgid = (int)L; { const int q = nwg / NXCD, r = nwg % NXCD, xcd = wgid % NXCD, off = wgid / NXCD; wgid = (xcd < r ? xcd * (q + 1) : r * (q + 1) + (xcd - r) * q) + off; }
        const int nig = WGM * nN, gid = wgid / nig, fm = gid * WGM, gsz = (nM - fm) < WGM ? (nM - fm) : WGM;
        u.pm = fm + ((wgid % nig) % gsz); u.pn = (wgid % nig) / gsz; return true;
    }
};

template <class Epi>
__device__ __forceinline__ void gemm_phase(LAS unsigned char* lds, const Gemm g, const StaticOrder& S, const Epi& E) {
    const int tid = tid_opaque(), wid = __builtin_amdgcn_readfirstlane(tid >> 6), lane = tid & 63, wr = wid >> 2, wc = wid & 3, fr = lane & 15, fq = lane >> 4;
    const int K = g.K, nt = K / BK;
    unsigned voffA[2], voffB[2];
#pragma unroll
    for (int i = 0; i < 2; ++i) { int R, C; stage_rc(tid * 16 + i * 8192, R, C); voffA[i] = (unsigned)(R * g.lda + C) * 2u; voffB[i] = (unsigned)(R * g.ldb + C) * 2u; }
    const size_t kstep = (size_t)(BK * 2);
    const size_t hstepA = (size_t)HALF * g.lda * 2, hstepB = (size_t)HALF * g.ldb * 2;
    const unsigned ldsw = (unsigned)wid * 1024u;
    const int aoff = lds_byte(wr * 64 + fr, fq * 8), boff = lds_byte(wc * 32 + fr, fq * 8);
#define PG8_SA(b, h) (((b) * 2 + (h)) * HTB)
#define PG8_SB(b, h) ((4 + (b) * 2 + (h)) * HTB)
#define PG8_STAGE(bufoff, gbase, voff) do { _Pragma("unroll") for (int _i = 0; _i < 2; ++_i) \
        __builtin_amdgcn_global_load_lds((const unsigned*)((const char*)(gbase) + (voff)[_i]), (LAS unsigned*)(lds + (bufoff) + ldsw + _i * 8192), 16, 0, 0); } while (0)
#define PG8_LDA(dst, b, h) do { _Pragma("unroll") for (int m = 0; m < 4; ++m) _Pragma("unroll") for (int k = 0; k < 2; ++k) dst[m][k] = *(const LAS bf16x8*)(lds + PG8_SA(b, h) + aoff + m * 2048 + k * 1024); } while (0)
#define PG8_LDB(dst, b, h) do { _Pragma("unroll") for (int n = 0; n < 2; ++n) _Pragma("unroll") for (int k = 0; k < 2; ++k) dst[n][k] = *(const LAS bf16x8*)(lds + PG8_SB(b, h) + boff + n * 2048 + k * 1024); } while (0)
#define PG8_MMA(ai, bj, At, Bt) do { __builtin_amdgcn_s_setprio(1); _Pragma("unroll") for (int m = 0; m < 4; ++m) _Pragma("unroll") for (int n = 0; n < 2; ++n) _Pragma("unroll") for (int k = 0; k < 2; ++k) \
        acc[ai][bj][m][n] = __builtin_amdgcn_mfma_f32_16x16x32_bf16(Bt[n][k], At[m][k], acc[ai][bj][m][n], 0, 0, 0); __builtin_amdgcn_s_setprio(0); } while (0)
#define PG8_WAIT_V(n) asm volatile("s_waitcnt vmcnt(" #n ")" ::: "memory")
#define PG8_WAIT_L(n) asm volatile("s_waitcnt lgkmcnt(" #n ")" ::: "memory")
#define PG8_BAR __builtin_amdgcn_s_barrier()
#define PG8_SCHED __builtin_amdgcn_sched_barrier(0)
    Unit cur, nxt; int ui = 0;
    if (!S.next(0, cur)) return;
    f32x4 acc[2][2][4][2];
#pragma unroll
    for (int a = 0; a < 2; ++a)
#pragma unroll
        for (int b = 0; b < 2; ++b)
#pragma unroll
            for (int m = 0; m < 4; ++m)
#pragma unroll
                for (int n = 0; n < 2; ++n) acc[a][b][m][n] = (f32x4){0.f, 0.f, 0.f, 0.f};
    bf16x8 At[4][2], B0[2][2], B1[2][2];
    const char* cA = g.abase(cur); const char* cB = g.bbase(cur);
    PG8_STAGE(PG8_SB(0, 0), cB, voffB); PG8_STAGE(PG8_SB(0, 1), cB + hstepB, voffB); PG8_STAGE(PG8_SA(0, 0), cA, voffA); PG8_STAGE(PG8_SA(0, 1), cA + hstepA, voffA);
    if (wr == 1) PG8_BAR;
    PG8_WAIT_V(2); PG8_BAR;
    PG8_STAGE(PG8_SB(1, 0), cB + kstep, voffB); PG8_STAGE(PG8_SA(1, 0), cA + kstep, voffA); PG8_STAGE(PG8_SB(1, 1), cB + hstepB + kstep, voffB);
    PG8_WAIT_V(6); PG8_BAR;
    for (;;) {
        const bool has_next = S.next(ui + 1, nxt);
        const char* nA = has_next ? g.abase(nxt) : cA; const char* nB = has_next ? g.bbase(nxt) : cB;
        for (int t = 0; t < nt; t += 2) {
            const bool last = (t == nt - 2);
            const char* a1 = cA + (size_t)(t + 1) * kstep;
            const char* a2 = last ? nA : cA + (size_t)(t + 2) * kstep; const char* b2 = last ? nB : cB + (size_t)(t + 2) * kstep;
            const char* a3 = a2 + kstep; const char* b3 = b2 + kstep;
            PG8_LDB(B0, 0, 0); PG8_LDB(B1, 0, 1); PG8_SCHED; PG8_LDA(At, 0, 0); PG8_STAGE(PG8_SA(1, 1), a1 + hstepA, voffA);
            PG8_WAIT_V(8); PG8_WAIT_L(0); PG8_BAR; PG8_MMA(0, 0, At, B0); PG8_MMA(0, 1, At, B1); PG8_BAR; PG8_SCHED;
            PG8_LDA(At, 0, 1); PG8_STAGE(PG8_SB(0, 0), b2, voffB); PG8_STAGE(PG8_SB(0, 1), b2 + hstepB, voffB); PG8_STAGE(PG8_SA(0, 0), a2, voffA);
            PG8_WAIT_V(8); PG8_WAIT_L(0); PG8_BAR; PG8_MMA(1, 0, At, B0); PG8_MMA(1, 1, At, B1); PG8_BAR; PG8_SCHED;
            PG8_LDB(B0, 1, 0); PG8_LDB(B1, 1, 1); PG8_SCHED; PG8_LDA(At, 1, 0); PG8_STAGE(PG8_SA(0, 1), a2 + hstepA, voffA);
            PG8_WAIT_V(8); PG8_WAIT_L(0); PG8_BAR; PG8_MMA(0, 0, At, B0); PG8_MMA(0, 1, At, B1); PG8_BAR; PG8_SCHED;
            PG8_LDA(At, 1, 1); PG8_STAGE(PG8_SB(1, 0), b3, voffB); PG8_STAGE(PG8_SB(1, 1), b3 + hstepB, voffB); PG8_STAGE(PG8_SA(1, 0), a3, voffA);
            PG8_WAIT_V(8); PG8_WAIT_L(0); PG8_BAR; PG8_MMA(1, 0, At, B0); PG8_MMA(1, 1, At, B1); PG8_BAR; PG8_SCHED;
        }
        if (wr == 0) PG8_BAR;
        E(acc, cur, wr, wc, fr, fq);
        if (!has_next) break;
#pragma unroll
        for (int a = 0; a < 2; ++a)
#pragma unroll
            for (int b = 0; b < 2; ++b)
#pragma unroll
                for (int m = 0; m < 4; ++m)
#pragma unroll
                    for (int n = 0; n < 2; ++n) acc[a][b][m][n] = (f32x4){0.f, 0.f, 0.f, 0.f};
        cur = nxt; cA = nA; cB = nB; ++ui;
        if (wr == 1) PG8_BAR;
    }
    PG8_WAIT_V(0);
    PG8_BAR;
#undef PG8_SA
#undef PG8_SB
#undef PG8_STAGE
#undef PG8_LDA
#undef PG8_LDB
#undef PG8_MMA
#undef PG8_WAIT_V
#undef PG8_WAIT_L
#undef PG8_BAR
#undef PG8_SCHED
}
}
using pg8::Unit; using pg8::Gemm; using pg8::StaticOrder;

struct Params {
    const float* x; const float* mem; const int* positions;
    const float* norm_mix_pre; const float* w_in; const float* conv_w; const float* a_log; const float* dt_bias; const float* gdn_norm; const float* w_out;
    const float* norm_mix_post; const float* norm_x_pre; const float* norm_mem; const float* w_xq; const float* w_xkv; const float* w_xo; const float* norm_x_post;
    const float* norm_ffn_pre; const float* w_gu; const float* w_down; const float* norm_ffn_post;
    float* out;
    unsigned* bar;
    bf16_t* wt;
    float* rope_cos; float* rope_sin;
    bf16_t* memn;
    bf16_t* xk;
    bf16_t* xvt;
    bf16_t* xn;
    bf16_t* qb;
    bf16_t* kb; bf16_t* vb; bf16_t* qib; bf16_t* kib;
    float* wi; float* gg; float* beta;
    bf16_t* raw;
    bf16_t* sel;
    bf16_t* halo;
    bf16_t* ta;
    float* npart;
};
typedef const __attribute__((address_space(4))) Params* KP;
constexpr long WT_IN = 0, WT_GATE = WT_IN + 5120l * 1024, WT_OUT = WT_GATE + 2048l * 1024, WT_XQ = WT_OUT + 1024l * 1024, WT_XKV = WT_XQ + 1024l * 1024,
               WT_XO = WT_XKV + 2048l * 1024, WT_GU = WT_XO + 1024l * 1024, WT_DOWN = WT_GU + 5632l * 1024, WT_LAYER = WT_DOWN + 1024l * 2816;

__device__ __forceinline__ int map_plain(int c) { return (c & ~31) + 8 * ((c >> 2) & 3) + 4 * ((c >> 4) & 1) + (c & 3); }
__device__ __forceinline__ int map_pair(int c, int second_off) {
    const int blk = c >> 7, wc = (c >> 5) & 3, n = (c >> 4) & 1, fq = (c >> 2) & 3, i = c & 3; const int cc = 64 * blk + 16 * wc + 4 * fq + i; return n ? second_off + cc : cc; }
__device__ __forceinline__ int map_in(int c) {
    const int pn = c >> 8, bj = (c >> 7) & 1, wc = (c >> 5) & 3, n = (c >> 4) & 1, fq = (c >> 2) & 3, i = c & 3;
    if (pn < 5) { const int head = (pn < 4) ? 2 * pn + bj : bj; const int d = n * 64 + 16 * wc + 4 * fq + i; return (pn < 4 ? OFF_AQ : OFF_AK) + head * 128 + d; }
    if (pn == 5) return OFF_AV + map_plain(c & 255);
    if (pn == 6) { const int head = 2 * bj + (wc >> 1); const int d = n * 32 + 16 * (wc & 1) + 4 * fq + i; return OFF_IQ + head * 64 + d; }
    if (pn == 7) {
        if (bj == 1 || wc == 3) return -1;
        if (wc < 2) return OFF_IK + n * 32 + 16 * wc + 4 * fq + i;
        const int s = 16 * n + 4 * fq + i;
        if (s < 4) return OFF_IW + s; if (s < 12) return OFF_BA + (s - 4); if (s < 20) return OFF_BB + (s - 12); return -1;
    }
    return OFF_BQKV + map_plain(c - 2048);
}
struct WtTile { const float* src; bf16_t* dst; int ld, K, n0, k0, kind, soff; };
__device__ __forceinline__ int wt_col(const WtTile& w, int c) { return w.kind == 0 ? map_plain(c) : (w.kind == 1 ? map_pair(c, w.soff) : map_in(c)); }
__device__ __forceinline__ void load_row_f32(const float* p, float (&v)[16]) {
#pragma unroll
    for (int j = 0; j < 4; ++j) { const f32x4 t = *(const f32x4*)(p + 4 * j); v[4 * j] = t[0]; v[4 * j + 1] = t[1]; v[4 * j + 2] = t[2]; v[4 * j + 3] = t[3]; }
}
__device__ __forceinline__ void load_row_bf16(const bf16_t* p, float (&v)[16]) {
#pragma unroll
    for (int j = 0; j < 2; ++j) { const u32x4 t = *(const u32x4*)(p + 8 * j);
        v[8 * j] = bflo(t.x); v[8 * j + 1] = bfhi(t.x); v[8 * j + 2] = bflo(t.y); v[8 * j + 3] = bfhi(t.y); v[8 * j + 4] = bflo(t.z); v[8 * j + 5] = bfhi(t.z); v[8 * j + 6] = bflo(t.w); v[8 * j + 7] = bfhi(t.w); }
}
__device__ __forceinline__ void store_row_bf16(bf16_t* p, const float (&v)[16]) {
#pragma unroll
    for (int j = 0; j < 2; ++j) { u32x4 w; w.x = cvt_pk_bf16(v[8 * j], v[8 * j + 1]); w.y = cvt_pk_bf16(v[8 * j + 2], v[8 * j + 3]); w.z = cvt_pk_bf16(v[8 * j + 4], v[8 * j + 5]); w.w = cvt_pk_bf16(v[8 * j + 6], v[8 * j + 7]);
        *(u32x4*)(p + 8 * j) = w; }
}
__device__ __forceinline__ void store_row_f32(float* p, const float (&v)[16]) {
#pragma unroll
    for (int j = 0; j < 4; ++j) *(f32x4*)(p + 4 * j) = (f32x4){v[4 * j], v[4 * j + 1], v[4 * j + 2], v[4 * j + 3]};
}
__device__ __forceinline__ void phase_norm_rows(const float* x, const float* g, bf16_t* xn, int nrows) {
    const int tid = tid_opaque(); const int lane = tid & 63, gw = blockIdx.x * NWAVES + (tid >> 6), nw = gridDim.x * NWAVES;
    float gv[16]; load_row_f32(g + lane * 16, gv);
    for (int r = gw; r < nrows; r += nw) {
        float v[16]; load_row_f32(x + (size_t)r * 1024 + lane * 16, v);
        float s = 0.f;
#pragma unroll
        for (int j = 0; j < 16; ++j) s += v[j] * v[j];
        s = wave_sum(s); const float rs = rsqrtf(s * (1.0f / 1024.f) + EPS);
#pragma unroll
        for (int j = 0; j < 16; ++j) v[j] = v[j] * rs * gv[j];
        store_row_bf16(xn + (size_t)r * 1024 + lane * 16, v);
    }
}
__device__ __forceinline__ void phase_prologue(KP p, LAS unsigned char* lds) {
    constexpr int T_IN = (5120 / 64) * 16, T_GATE = (2048 / 64) * 16, T_SQ = 16 * 16, T_XKV = 32 * 16, T_GU = (5632 / 64) * 16, T_DOWN = 16 * 44;
    constexpr int T_LAYER = T_IN + T_GATE + 3 * T_SQ + T_XKV + T_GU + T_DOWN;
    auto decode = [&](int t) -> WtTile {
        const int l = t / T_LAYER; int r = t % T_LAYER; bf16_t* wl = p->wt + (size_t)l * WT_LAYER; WtTile w;
        if (r < T_IN) { w = WtTile{p->w_in + (size_t)l * 1024 * IN_COLS, wl + WT_IN, IN_COLS, 1024, (r >> 4) * 64, (r & 15) * 64, 2, 0}; return w; } r -= T_IN;
        if (r < T_GATE) { w = WtTile{p->w_in + (size_t)l * 1024 * IN_COLS + OFF_GA, wl + WT_GATE, IN_COLS, 1024, (r >> 4) * 64, (r & 15) * 64, 1, 1024}; return w; } r -= T_GATE;
        if (r < T_SQ) { w = WtTile{p->w_out + (size_t)l * 1024 * 1024, wl + WT_OUT, 1024, 1024, (r >> 4) * 64, (r & 15) * 64, 0, 0}; return w; } r -= T_SQ;
        if (r < T_SQ) { w = WtTile{p->w_xq + (size_t)l * 1024 * 1024, wl + WT_XQ, 1024, 1024, (r >> 4) * 64, (r & 15) * 64, 0, 0}; return w; } r -= T_SQ;
        if (r < T_XKV) { w = WtTile{p->w_xkv + (size_t)l * 1024 * 2048, wl + WT_XKV, 2048, 1024, (r >> 4) * 64, (r & 15) * 64, 0, 0}; return w; } r -= T_XKV;
        if (r < T_SQ) { w = WtTile{p->w_xo + (size_t)l * 1024 * 1024, wl + WT_XO, 1024, 1024, (r >> 4) * 64, (r & 15) * 64, 0, 0}; return w; } r -= T_SQ;
        if (r < T_GU) { w = WtTile{p->w_gu + (size_t)l * 1024 * 5632, wl + WT_GU, 5632, 1024, (r >> 4) * 64, (r & 15) * 64, 1, 2816}; return w; } r -= T_GU;
        w = WtTile{p->w_down + (size_t)l * 2816 * 1024, wl + WT_DOWN, 1024, 2816, (r / 44) * 64, (r % 44) * 64, 0, 0}; return w; };
    { const int tid = tid_opaque(); const int nl = tid & 63, kb = tid >> 6, nl2 = tid >> 3, kk = (tid & 7) * 8;
      for (int t0 = blockIdx.x; t0 < 2 * T_LAYER; t0 += 4 * gridDim.x) {
          float v[4][8];
#pragma unroll
          for (int g = 0; g < 4; ++g) { const int t = t0 + g * gridDim.x;
              if (t < 2 * T_LAYER) { const WtTile w = decode(t); const int col = wt_col(w, w.n0 + nl);
#pragma unroll
                  for (int q = 0; q < 8; ++q) v[g][q] = col >= 0 ? w.src[(size_t)(w.k0 + q * 8 + kb) * w.ld + col] : 0.f; } }
#pragma unroll
          for (int g = 0; g < 4; ++g) { const int t = t0 + g * gridDim.x; LAS float* tile = (LAS float*)lds + g * (64 * 65);
              if (t < 2 * T_LAYER) {
#pragma unroll
                  for (int q = 0; q < 8; ++q) tile[(q * 8 + kb) * 65 + nl] = v[g][q]; } }
          __syncthreads();
#pragma unroll
          for (int g = 0; g < 4; ++g) { const int t = t0 + g * gridDim.x; const LAS float* tile = (const LAS float*)lds + g * (64 * 65);
              if (t < 2 * T_LAYER) { const WtTile w = decode(t); float x[8];
#pragma unroll
                  for (int j = 0; j < 8; ++j) x[j] = tile[(kk + j) * 65 + nl2];
                  u32x4 o; o.x = cvt_pk_bf16(x[0], x[1]); o.y = cvt_pk_bf16(x[2], x[3]); o.z = cvt_pk_bf16(x[4], x[5]); o.w = cvt_pk_bf16(x[6], x[7]);
                  *(u32x4*)(w.dst + (size_t)(w.n0 + nl2) * w.K + w.k0 + kk) = o; } }
          __syncthreads();
      } }
    for (size_t i = (size_t)blockIdx.x * NTHREADS + tid_opaque(); i < (size_t)MTOK * 64; i += (size_t)gridDim.x * NTHREADS) {
        const int m = (int)(i >> 6), j = (int)(i & 63);
        const float inv_freq = exp2f(-(float)j * 0.20762050593046015f);
        const double a = (double)p->positions[m] * (double)inv_freq * 0.15915494309189535;
        const float fr = (float)(a - floor(a));
        p->rope_cos[i] = __builtin_amdgcn_cosf(fr); p->rope_sin[i] = __builtin_amdgcn_sinf(fr);
    }
    phase_norm_rows(p->mem, p->norm_mem, p->memn, BATCH * N_MEM);
    phase_norm_rows(p->mem, p->norm_mem + 1024, p->memn + (size_t)BATCH * N_MEM * 1024, BATCH * N_MEM);
    phase_norm_rows(p->x, p->norm_mix_pre, p->xn, MTOK);
}

struct EpiPlain {
    bf16_t* O; int ldc; float scale;
    __device__ __forceinline__ void operator()(const f32x4 (&acc)[2][2][4][2], const Unit& u, int wr, int wc, int fr, int fq) const {
        const int row0 = u.pm * 256 + wr * 64 + fr, col0 = u.pn * 256 + wc * 32 + 8 * fq;
#pragma unroll
        for (int ai = 0; ai < 2; ++ai)
#pragma unroll
            for (int m = 0; m < 4; ++m) { bf16_t* rowp = O + (size_t)(row0 + ai * 128 + m * 16) * ldc + col0;
#pragma unroll
                for (int bj = 0; bj < 2; ++bj) { const f32x4 v0 = acc[ai][bj][m][0] * scale, v1 = acc[ai][bj][m][1] * scale;
                    u32x4 w; w.x = cvt_pk_bf16(v0[0], v0[1]); w.y = cvt_pk_bf16(v0[2], v0[3]); w.z = cvt_pk_bf16(v1[0], v1[1]); w.w = cvt_pk_bf16(v1[2], v1[3]);
                    *(u32x4*)(rowp + bj * 128) = w; } }
    }
};
struct EpiF32 {
    float* C; int ldc;
    __device__ __forceinline__ void operator()(const f32x4 (&acc)[2][2][4][2], const Unit& u, int wr, int wc, int fr, int fq) const {
        const int row0 = u.pm * 256 + wr * 64 + fr, col0 = u.pn * 256 + wc * 32 + 4 * fq;
#pragma unroll
        for (int ai = 0; ai < 2; ++ai)
#pragma unroll
            for (int m = 0; m < 4; ++m) { float* rowp = C + (size_t)(row0 + ai * 128 + m * 16) * ldc + col0;
#pragma unroll
                for (int bj = 0; bj < 2; ++bj)
#pragma unroll
                    for (int n = 0; n < 2; ++n) *(f32x4*)(rowp + bj * 128 + n * 16) = acc[ai][bj][m][n]; }
    }
};
struct EpiSoftmaxP {
    bf16_t* P; LAS unsigned char* xl;
    __device__ __forceinline__ void operator()(const f32x4 (&acc)[2][2][4][2], const Unit& u, int wr, int wc, int fr, int fq) const {
        LAS float* mxs = (LAS float*)xl; LAS float* sms = mxs + 1024;
        const int rl0 = wr * 64 + fr;
        float rmax[2][4];
#pragma unroll
        for (int ai = 0; ai < 2; ++ai)
#pragma unroll
            for (int m = 0; m < 4; ++m) { float mx = -INFINITY;
#pragma unroll
                for (int bj = 0; bj < 2; ++bj)
#pragma unroll
                    for (int n = 0; n < 2; ++n) { const f32x4 v = acc[ai][bj][m][n]; mx = fmaxf(mx, fmaxf(fmaxf(v[0], v[1]), fmaxf(v[2], v[3]))); }
                mx = fmaxf(mx, __shfl_xor(mx, 16)); mx = fmaxf(mx, __shfl_xor(mx, 32));
                if (fq == 0) mxs[(rl0 + ai * 128 + m * 16) * 4 + wc] = mx; }
        asm volatile("s_waitcnt lgkmcnt(0)" ::: "memory"); __builtin_amdgcn_s_barrier(); asm volatile("" ::: "memory");
        float p[2][4][16];
#pragma unroll
        for (int ai = 0; ai < 2; ++ai)
#pragma unroll
            for (int m = 0; m < 4; ++m) { const f32x4 q = *(const LAS f32x4*)(mxs + (rl0 + ai * 128 + m * 16) * 4); const float mx = fmaxf(fmaxf(q[0], q[1]), fmaxf(q[2], q[3])); rmax[ai][m] = mx; float sm = 0.f;
#pragma unroll
                for (int bj = 0; bj < 2; ++bj)
#pragma unroll
                    for (int n = 0; n < 2; ++n)
#pragma unroll
                        for (int i = 0; i < 4; ++i) { const float e = __expf(acc[ai][bj][m][n][i] - mx); p[ai][m][bj * 8 + n * 4 + i] = e; sm += e; }
                sm += __shfl_xor(sm, 16); sm += __shfl_xor(sm, 32);
                if (fq == 0) sms[(rl0 + ai * 128 + m * 16) * 4 + wc] = sm; }
        asm volatile("s_waitcnt lgkmcnt(0)" ::: "memory"); __builtin_amdgcn_s_barrier(); asm volatile("" ::: "memory");
        const int row0 = u.pm * 256 + wr * 64 + fr, col0 = u.pn * 256 + wc * 32 + 4 * fq;
#pragma unroll
        for (int ai = 0; ai < 2; ++ai)
#pragma unroll
            for (int m = 0; m < 4; ++m) { const f32x4 q = *(const LAS f32x4*)(sms + (rl0 + ai * 128 + m * 16) * 4); const float inv = 1.0f / ((q[0] + q[1]) + (q[2] + q[3]));
                bf16_t* rowp = P + (size_t)(row0 + ai * 128 + m * 16) * 1024 + col0;
#pragma unroll
                for (int bj = 0; bj < 2; ++bj)
#pragma unroll
                    for (int n = 0; n < 2; ++n) { u32x2 w; w.x = cvt_pk_bf16(p[ai][m][bj * 8 + n * 4] * inv, p[ai][m][bj * 8 + n * 4 + 1] * inv); w.y = cvt_pk_bf16(p[ai][m][bj * 8 + n * 4 + 2] * inv, p[ai][m][bj * 8 + n * 4 + 3] * inv);
                        *(u32x2*)(rowp + bj * 128 + n * 16) = w; } }
        (void)rmax;
    }
};
struct EpiNormFused {
    const float* xin; float* xout; bf16_t* xn; const float* gpost; const float* gpre; float* part; unsigned* cnt; LAS unsigned char* xl;
    __device__ __forceinline__ float exchange(const float (&rowss)[2][4], int which, const Unit& u, int wr, int wc, int fr, int fq) const {
        LAS float* ps = (LAS float*)xl; LAS float* rs = ps + 1024;
        const int tid = (wr * 4 + wc) * 64 + fq * 16 + fr;
#pragma unroll
        for (int ai = 0; ai < 2; ++ai)
#pragma unroll
            for (int m = 0; m < 4; ++m) if (fq == 0) ps[(wr * 64 + fr + ai * 128 + m * 16) * 4 + wc] = rowss[ai][m];
        asm volatile("s_waitcnt lgkmcnt(0)" ::: "memory"); __builtin_amdgcn_s_barrier(); asm volatile("" ::: "memory");
        float* pp = part + (size_t)which * MTOK * 4; unsigned* cc = cnt + (which * 128 + u.pm) * 16;
        if (tid < 256) { const f32x4 q = *(const LAS f32x4*)(ps + tid * 4); const float tot = (q[0] + q[1]) + (q[2] + q[3]);
            __hip_atomic_store((unsigned*)(pp + ((size_t)u.pm * 256 + tid) * 4 + u.pn), __float_as_uint(tot), __ATOMIC_RELAXED, __HIP_MEMORY_SCOPE_AGENT); }
        asm volatile("s_waitcnt vmcnt(0)" ::: "memory"); __builtin_amdgcn_s_barrier(); asm volatile("" ::: "memory");
        if (tid == 0) (void)__hip_atomic_fetch_add(cc, 1u, __ATOMIC_RELAXED, __HIP_MEMORY_SCOPE_AGENT);
        if (tid < 64) { unsigned sp = 0; while ((unsigned)__builtin_amdgcn_readfirstlane((int)__hip_atomic_load(cc, __ATOMIC_RELAXED, __HIP_MEMORY_SCOPE_AGENT)) < 4u) { __builtin_amdgcn_s_sleep(2); if (++sp > (1u << 22)) break; } }
        asm volatile("" ::: "memory"); __builtin_amdgcn_s_barrier(); asm volatile("" ::: "memory");
        if (tid < 256) { const unsigned* gp = (const unsigned*)(pp + ((size_t)u.pm * 256 + tid) * 4);
            const float a = __uint_as_float(__hip_atomic_load(gp, __ATOMIC_RELAXED, __HIP_MEMORY_SCOPE_AGENT)), b = __uint_as_float(__hip_atomic_load(gp + 1, __ATOMIC_RELAXED, __HIP_MEMORY_SCOPE_AGENT)),
                        c = __uint_as_float(__hip_atomic_load(gp + 2, __ATOMIC_RELAXED, __HIP_MEMORY_SCOPE_AGENT)), d = __uint_as_float(__hip_atomic_load(gp + 3, __ATOMIC_RELAXED, __HIP_MEMORY_SCOPE_AGENT));
            rs[tid] = rsqrtf(((a + b) + (c + d)) * (1.0f / 1024.f) + EPS); }
        asm volatile("s_waitcnt lgkmcnt(0)" ::: "memory"); __builtin_amdgcn_s_barrier(); asm volatile("" ::: "memory");
        return 0.f;
    }
    __device__ __forceinline__ void operator()(const f32x4 (&acc)[2][2][4][2], const Unit& u, int wr, int wc, int fr, int fq) const {
        LAS float* rs = (LAS float*)xl + 1024;
        f32x4 y[2][2][4][2];
        float ss[2][4];
#pragma unroll
        for (int ai = 0; ai < 2; ++ai)
#pragma unroll
            for (int m = 0; m < 4; ++m) { float sacc = 0.f;
#pragma unroll
                for (int bj = 0; bj < 2; ++bj)
#pragma unroll
                    for (int n = 0; n < 2; ++n) { const f32x4 v = acc[ai][bj][m][n]; y[ai][bj][m][n] = v; sacc += (v[0] * v[0] + v[1] * v[1]) + (v[2] * v[2] + v[3] * v[3]); }
                sacc += __shfl_xor(sacc, 16); sacc += __shfl_xor(sacc, 32); ss[ai][m] = sacc; }
        (void)exchange(ss, 0, u, wr, wc, fr, fq);
        const int row0 = u.pm * 256 + wr * 64 + fr, col0 = u.pn * 256 + wc * 32 + 8 * fq;
#pragma unroll
        for (int ai = 0; ai < 2; ++ai)
#pragma unroll
            for (int m = 0; m < 4; ++m) { const int rl = wr * 64 + fr + ai * 128 + m * 16; const float r1 = rs[rl]; const size_t ro = (size_t)(row0 + ai * 128 + m * 16) * 1024; float sacc = 0.f;
#pragma unroll
                for (int bj = 0; bj < 2; ++bj)
#pragma unroll
                    for (int n = 0; n < 2; ++n) { const int c = col0 + bj * 128 + 4 * n; const f32x4 xv = *(const f32x4*)(xin + ro + c), gv = *(const f32x4*)(gpost + c);
                        const f32x4 v = xv + y[ai][bj][m][n] * r1 * gv; y[ai][bj][m][n] = v; *(f32x4*)(xout + ro + c) = v; sacc += (v[0] * v[0] + v[1] * v[1]) + (v[2] * v[2] + v[3] * v[3]); }
                sacc += __shfl_xor(sacc, 16); sacc += __shfl_xor(sacc, 32); ss[ai][m] = sacc; }
        if (!gpre) return;
        (void)exchange(ss, 1, u, wr, wc, fr, fq);
#pragma unroll
        for (int ai = 0; ai < 2; ++ai)
#pragma unroll
            for (int m = 0; m < 4; ++m) { const int rl = wr * 64 + fr + ai * 128 + m * 16; const float r2 = rs[rl]; const size_t ro = (size_t)(row0 + ai * 128 + m * 16) * 1024;
#pragma unroll
                for (int bj = 0; bj < 2; ++bj) { const int c = col0 + bj * 128; const f32x4 g0 = *(const f32x4*)(gpre + c), g1 = *(const f32x4*)(gpre + c + 4);
                    const f32x4 v0 = y[ai][bj][m][0] * r2 * g0, v1 = y[ai][bj][m][1] * r2 * g1;
                    u32x4 w; w.x = cvt_pk_bf16(v0[0], v0[1]); w.y = cvt_pk_bf16(v0[2], v0[3]); w.z = cvt_pk_bf16(v1[0], v1[1]); w.w = cvt_pk_bf16(v1[2], v1[3]);
                    *(u32x4*)(xn + ro + c) = w; } }
    }
};
struct EpiXKV {
    bf16_t* XK; bf16_t* XVT;
    __device__ __forceinline__ void operator()(const f32x4 (&acc)[2][2][4][2], const Unit& u, int wr, int wc, int fr, int fq) const {
        const int row0 = u.pm * 256 + wr * 64 + fr;
        if (u.pn < 4) { EpiPlain e{XK, 1024, 1.0f}; e(acc, u, wr, wc, fr, fq); return; }
        const int hx = u.pn - 4;
#pragma unroll
        for (int ai = 0; ai < 2; ++ai)
#pragma unroll
            for (int m = 0; m < 4; ++m) { const int r = row0 + ai * 128 + m * 16; const int lb = r >> 8, key = r & 255;
                bf16_t* base = XVT + ((size_t)(lb * 4 + hx) * 256) * 256 + key;
#pragma unroll
                for (int bj = 0; bj < 2; ++bj)
#pragma unroll
                    for (int n = 0; n < 2; ++n)
#pragma unroll
                        for (int i = 0; i < 4; ++i) { const int pos = bj * 128 + wc * 32 + 16 * n + 4 * fq + i; base[(size_t)pos * 256] = f2bf(acc[ai][bj][m][n][i]); } }
    }
};
struct EpiSwiGLU {
    bf16_t* F;
    __device__ __forceinline__ void operator()(const f32x4 (&acc)[2][2][4][2], const Unit& u, int wr, int wc, int fr, int fq) const {
        const int row0 = u.pm * 256 + wr * 64 + fr;
#pragma unroll
        for (int ai = 0; ai < 2; ++ai)
#pragma unroll
            for (int m = 0; m < 4; ++m) { bf16_t* rowp = F + (size_t)(row0 + ai * 128 + m * 16) * FF;
#pragma unroll
                for (int bj = 0; bj < 2; ++bj) { const int cc = 64 * (2 * u.pn + bj) + 16 * wc + 4 * fq; const f32x4 g = acc[ai][bj][m][0], up = acc[ai][bj][m][1]; float o[4];
#pragma unroll
                    for (int i = 0; i < 4; ++i) o[i] = g[i] * sigmoidf_(g[i]) * up[i];
                    u32x2 w; w.x = cvt_pk_bf16(o[0], o[1]); w.y = cvt_pk_bf16(o[2], o[3]); *(u32x2*)(rowp + cc) = w; } }
    }
};
struct EpiGates {
    bf16_t* Y; const bf16_t* ya; const bf16_t* yb; const float* gnorm; LAS unsigned char* xl;
    __device__ __forceinline__ void operator()(const f32x4 (&acc)[2][2][4][2], const Unit& u, int wr, int wc, int fr, int fq) const {
        LAS float* sms = (LAS float*)xl;
        const int row0 = u.pm * 256 + wr * 64 + fr, rl0 = wr * 64 + fr;
        u32x2 braw[2][4][2];
#pragma unroll
        for (int ai = 0; ai < 2; ++ai)
#pragma unroll
            for (int m = 0; m < 4; ++m) { const size_t r = (size_t)(row0 + ai * 128 + m * 16); float ss = 0.f;
#pragma unroll
                for (int bj = 0; bj < 2; ++bj) { const int cc = 64 * (2 * u.pn + bj) + 16 * wc + 4 * fq; const u32x2 b = *(const u32x2*)(yb + r * 1024 + cc); braw[ai][m][bj] = b;
                    const float b0 = bflo(b.x), b1 = bfhi(b.x), b2 = bflo(b.y), b3 = bfhi(b.y); ss += (b0 * b0 + b1 * b1) + (b2 * b2 + b3 * b3); }
                ss += __shfl_xor(ss, 16); ss += __shfl_xor(ss, 32);
                if (fq == 0) sms[(rl0 + ai * 128 + m * 16) * 4 + wc] = ss; }
        asm volatile("s_waitcnt lgkmcnt(0)" ::: "memory"); __builtin_amdgcn_s_barrier(); asm volatile("" ::: "memory");
#pragma unroll
        for (int ai = 0; ai < 2; ++ai)
#pragma unroll
            for (int m = 0; m < 4; ++m) { const size_t r = (size_t)(row0 + ai * 128 + m * 16);
                const f32x4 q = *(const LAS f32x4*)(sms + (rl0 + ai * 128 + m * 16) * 4); const float rs = rsqrtf(((q[0] + q[1]) + (q[2] + q[3])) * (1.0f / 128.f) + EPS);
#pragma unroll
                for (int bj = 0; bj < 2; ++bj) { const int cc = 64 * (2 * u.pn + bj) + 16 * wc + 4 * fq; const f32x4 ga = acc[ai][bj][m][0], gb = acc[ai][bj][m][1];
                    const u32x2 a = *(const u32x2*)(ya + r * 1024 + cc), b = braw[ai][m][bj]; const f32x4 gv = *(const f32x4*)(gnorm + (cc & 127));
                    const float av[4] = {bflo(a.x), bfhi(a.x), bflo(a.y), bfhi(a.y)}, bv[4] = {bflo(b.x), bfhi(b.x), bflo(b.y), bfhi(b.y)}; float o[4];
#pragma unroll
                    for (int i = 0; i < 4; ++i) o[i] = sigmoidf_(ga[i]) * av[i] + sigmoidf_(gb[i]) * (bv[i] * rs * gv[i]);
                    u32x2 w; w.x = cvt_pk_bf16(o[0], o[1]); w.y = cvt_pk_bf16(o[2], o[3]); *(u32x2*)(Y + r * 1024 + cc) = w; } }
    }
};
struct EpiInProj {
    KP e; int layer;
    __device__ __forceinline__ void operator()(const f32x4 (&acc)[2][2][4][2], const Unit& u, int wr, int wc, int fr, int fq) const {
        const int row0 = u.pm * 256 + wr * 64 + fr, pn = u.pn;
        if (pn == 5 || pn >= 8) {
            bf16_t* O = (pn == 5) ? e->vb : e->raw + (size_t)((pn - 8) >> 2) * MTOK * 1024 + ((pn - 8) & 3) * 256; const int ldc = (pn == 5) ? 256 : 1024;
#pragma unroll
            for (int ai = 0; ai < 2; ++ai)
#pragma unroll
                for (int m = 0; m < 4; ++m) { bf16_t* rowp = O + (size_t)(row0 + ai * 128 + m * 16) * ldc + wc * 32 + 8 * fq;
#pragma unroll
                    for (int bj = 0; bj < 2; ++bj) { const f32x4 v0 = acc[ai][bj][m][0], v1 = acc[ai][bj][m][1];
                        u32x4 w; w.x = cvt_pk_bf16(v0[0], v0[1]); w.y = cvt_pk_bf16(v0[2], v0[3]); w.z = cvt_pk_bf16(v1[0], v1[1]); w.w = cvt_pk_bf16(v1[2], v1[3]);
                        *(u32x4*)(rowp + bj * 128) = w;
                        if (m == 3 && fr >= 13 && pn >= 8 && pn < 16) {
                            const int r = row0 + ai * 128 + m * 16;
                            *(u32x4*)(e->halo + ((size_t)(r >> 6) * 3 + ((r & 63) - 61)) * 2048 + (pn - 8) * 256 + bj * 128 + wc * 32 + 8 * fq) = w; } } }
            return;
        }
        if (pn < 5) {
            const float sc = (pn < 4) ? 0.08838834764831845f : 1.0f; bf16_t* O = (pn < 4) ? e->qb : e->kb; const int ldc = (pn < 4) ? 1024 : 256; const int d0 = 16 * wc + 4 * fq;
#pragma unroll
            for (int ai = 0; ai < 2; ++ai)
#pragma unroll
                for (int m = 0; m < 4; ++m) { const size_t r = (size_t)(row0 + ai * 128 + m * 16);
                    const f32x4 c = *(const f32x4*)(e->rope_cos + r * 64 + d0), s = *(const f32x4*)(e->rope_sin + r * 64 + d0);
#pragma unroll
                    for (int bj = 0; bj < 2; ++bj) { const int head = (pn < 4) ? 2 * pn + bj : bj; const f32x4 x1 = acc[ai][bj][m][0], x2 = acc[ai][bj][m][1];
                        const f32x4 o1 = (x1 * c - x2 * s) * sc, o2 = (x2 * c + x1 * s) * sc;
                        u32x2 w1, w2; w1.x = cvt_pk_bf16(o1[0], o1[1]); w1.y = cvt_pk_bf16(o1[2], o1[3]); w2.x = cvt_pk_bf16(o2[0], o2[1]); w2.y = cvt_pk_bf16(o2[2], o2[3]);
                        *(u32x2*)(O + r * ldc + head * 128 + d0) = w1; *(u32x2*)(O + r * ldc + head * 128 + 64 + d0) = w2; } }
            return;
        }
        if (pn == 7 && wc >= 2) {
            if (wc == 2) {
#pragma unroll
                for (int ai = 0; ai < 2; ++ai)
#pragma unroll
                    for (int m = 0; m < 4; ++m) { const size_t r = (size_t)(row0 + ai * 128 + m * 16);
#pragma unroll
                        for (int n = 0; n < 2; ++n)
#pragma unroll
                            for (int i = 0; i < 4; ++i) { const int sidx = 16 * n + 4 * fq + i; const float v = acc[ai][0][m][n][i];
                                if (sidx < 4) e->wi[r * 4 + sidx] = v * 0.5f;
                                else if (sidx < 12) { const int h = sidx - 4; const float z = v + e->dt_bias[layer * 8 + h]; const float sp = fmaxf(z, 0.f) + __logf(1.0f + __expf(-fabsf(z))); e->gg[r * 8 + h] = -__expf(e->a_log[layer * 8 + h]) * sp; }
                                else if (sidx < 20) { const int h = sidx - 12; e->beta[r * 8 + h] = sigmoidf_(v); } } }
            }
            return;
        }
        const int d0 = 16 * (wc & 1) + 4 * fq;
#pragma unroll
        for (int ai = 0; ai < 2; ++ai)
#pragma unroll
            for (int m = 0; m < 4; ++m) { const size_t r = (size_t)(row0 + ai * 128 + m * 16);
                const f32x4 ca = *(const f32x4*)(e->rope_cos + r * 64 + 2 * d0), cb = *(const f32x4*)(e->rope_cos + r * 64 + 2 * d0 + 4);
                const f32x4 sa = *(const f32x4*)(e->rope_sin + r * 64 + 2 * d0), sb = *(const f32x4*)(e->rope_sin + r * 64 + 2 * d0 + 4);
                const f32x4 c = (f32x4){ca[0], ca[2], cb[0], cb[2]}, s = (f32x4){sa[0], sa[2], sb[0], sb[2]};
                if (pn == 6) {
#pragma unroll
                    for (int bj = 0; bj < 2; ++bj) { const int head = 2 * bj + (wc >> 1); const f32x4 x1 = acc[ai][bj][m][0], x2 = acc[ai][bj][m][1];
                        const f32x4 o1 = (x1 * c - x2 * s) * 0.125f, o2 = (x2 * c + x1 * s) * 0.125f;
                        u32x2 w1, w2; w1.x = cvt_pk_bf16(o1[0], o1[1]); w1.y = cvt_pk_bf16(o1[2], o1[3]); w2.x = cvt_pk_bf16(o2[0], o2[1]); w2.y = cvt_pk_bf16(o2[2], o2[3]);
                        *(u32x2*)(e->qib + r * 256 + head * 64 + d0) = w1; *(u32x2*)(e->qib + r * 256 + head * 64 + 32 + d0) = w2; }
                } else {
                    const f32x4 x1 = acc[ai][0][m][0], x2 = acc[ai][0][m][1];
                    const f32x4 o1 = x1 * c - x2 * s, o2 = x2 * c + x1 * s;
                    u32x2 w1, w2; w1.x = cvt_pk_bf16(o1[0], o1[1]); w1.y = cvt_pk_bf16(o1[2], o1[3]); w2.x = cvt_pk_bf16(o2[0], o2[1]); w2.y = cvt_pk_bf16(o2[2], o2[3]);
                    *(u32x2*)(e->kib + r * 64 + d0) = w1; *(u32x2*)(e->kib + r * 64 + 32 + d0) = w2;
                }
            }
    }
};

__device__ __forceinline__ void phase_gdn_prep(KP p, int layer, LAS unsigned char* lds) {
    const int tid = tid_opaque(), lane0 = tid & 63, wid = __builtin_amdgcn_readfirstlane(tid >> 6);
    LAS float* Ms = (LAS float*)(lds + wid * 16896);
    LAS float* gcs = Ms + 4096;
    const float* cw = p->conv_w + (size_t)layer * 4 * 3072;
    for (int item = blockIdx.x * NWAVES + wid; item < 4096; item += gridDim.x * NWAVES) {
        int lane = lane0; asm volatile("" : "+v"(lane));
        const int n = lane & 15, g = lane >> 4;
        const int c = item & 255, h = (item >> 8) & 7, b = item >> 11;
        const size_t m0 = (size_t)b * SEQ + 64 * c;
#pragma unroll 1
        for (int which = 0; which < 2; ++which) {
            bf16_t* rp = p->raw + (size_t)which * MTOK * 1024 + m0 * 1024 + h * 128 + 2 * lane;
            const int cc = which * 1024 + h * 128 + 2 * lane;
            float w[4][2];
#pragma unroll
            for (int j = 0; j < 4; ++j) { w[j][0] = cw[j * 3072 + cc]; w[j][1] = cw[j * 3072 + cc + 1]; }
            float hs[3][2];
#pragma unroll
            for (int j = 0; j < 3; ++j) { hs[j][0] = 0.f; hs[j][1] = 0.f; }
            if (c > 0) { const bf16_t* hp = p->halo + ((size_t)(m0 / 64 - 1) * 3) * 2048 + cc;
#pragma unroll
                for (int j = 0; j < 3; ++j) { const unsigned u = *(const unsigned*)(hp + j * 2048); hs[j][0] = bflo(u); hs[j][1] = bfhi(u); } }
            const float post = which == 0 ? 0.08838834764831845f : 1.0f;
            unsigned raw64[64];
#pragma unroll
            for (int r = 0; r < 64; ++r) raw64[r] = *(const unsigned*)(rp + (size_t)r * 1024);
#pragma unroll
            for (int r = 0; r < 64; ++r) {
                const float x0 = bflo(raw64[r]), x1 = bfhi(raw64[r]);
                float y0 = w[0][0] * hs[0][0] + w[1][0] * hs[1][0] + w[2][0] * hs[2][0] + w[3][0] * x0;
                float y1 = w[0][1] * hs[0][1] + w[1][1] * hs[1][1] + w[2][1] * hs[2][1] + w[3][1] * x1;
                hs[0][0] = hs[1][0]; hs[1][0] = hs[2][0]; hs[2][0] = x0; hs[0][1] = hs[1][1]; hs[1][1] = hs[2][1]; hs[2][1] = x1;
                y0 = y0 * sigmoidf_(y0); y1 = y1 * sigmoidf_(y1);
                const float ss = wave_sum(y0 * y0 + y1 * y1);
                const float rs = rsqrtf(ss + EPS) * post;
                *(unsigned*)(rp + (size_t)r * 1024) = cvt_pk_bf16(y0 * rs, y1 * rs);
            }
        }
        float gcv = p->gg[(m0 + lane) * 8 + h];
#pragma unroll
        for (int o = 1; o < 64; o <<= 1) { const float t = __shfl_up(gcv, o); if (lane >= o) gcv += t; }
        const float bev = p->beta[(m0 + lane) * 8 + h];
        p->gg[(m0 + lane) * 8 + h] = gcv;
        gcs[lane] = gcv; gcs[64 + lane] = bev;
        asm volatile("s_waitcnt vmcnt(0)" ::: "memory");
        bf16x8 kf[4][4];
        const bf16_t* kq = p->raw + m0 * 1024 + h * 128 + 8 * g + (size_t)n * 1024;
#pragma unroll
        for (int mt = 0; mt < 4; ++mt)
#pragma unroll
            for (int ks = 0; ks < 4; ++ks) kf[mt][ks] = *(const bf16x8*)(kq + (size_t)MTOK * 1024 + (size_t)mt * 16 * 1024 + 32 * ks);
        bf16_t* tout = (layer == 0 ? (bf16_t*)p->out : p->ta) + (size_t)item * 8192; bf16_t* aout = tout + 4096;
#pragma unroll
        for (int mt = 0; mt < 4; ++mt) {
            bf16x8 qf[4];
#pragma unroll
            for (int ks = 0; ks < 4; ++ks) qf[ks] = *(const bf16x8*)(kq + (size_t)mt * 16 * 1024 + 32 * ks);
            const f32x4 gi = *(const LAS f32x4*)(gcs + 16 * mt + 4 * g), bi = *(const LAS f32x4*)(gcs + 64 + 16 * mt + 4 * g);
#pragma unroll
            for (int nt = 0; nt < 4; ++nt) {
                f32x4 aK = (f32x4){0.f, 0.f, 0.f, 0.f}, aQ = (f32x4){0.f, 0.f, 0.f, 0.f};
                if (nt <= mt) {
#pragma unroll
                    for (int ks = 0; ks < 4; ++ks) { aK = __builtin_amdgcn_mfma_f32_16x16x32_bf16(kf[mt][ks], kf[nt][ks], aK, 0, 0, 0); aQ = __builtin_amdgcn_mfma_f32_16x16x32_bf16(qf[ks], kf[nt][ks], aQ, 0, 0, 0); }
                }
                const float gj = gcs[16 * nt + n]; const int j = 16 * nt + n;
#pragma unroll
                for (int r = 0; r < 4; ++r) { const int i = 16 * mt + 4 * g + r;
                    const float dec = (j <= i) ? __expf(gi[r] - gj) : 0.f;
                    Ms[i * 64 + j] = (j < i) ? bi[r] * aK[r] * dec : 0.f;
                    aout[i * 64 + j] = f2bf(aQ[r] * dec); }
            }
        }
        float Tc[64];
#pragma unroll
        for (int i = 0; i < 64; ++i) {
            float acc = (lane == i) ? 1.f : 0.f;
#pragma unroll
            for (int j4 = 0; j4 < i; j4 += 4) { const f32x4 mv = *(const LAS f32x4*)(Ms + i * 64 + j4);
#pragma unroll
                for (int jj = 0; jj < 4; ++jj) if (j4 + jj < i) acc -= mv[jj] * Tc[j4 + jj]; }
            Tc[i] = acc;
            tout[i * 64 + lane] = f2bf(acc);
            asm volatile("" ::: "memory");
        }
    }
}

__device__ __forceinline__ unsigned lds_addr32(LAS unsigned char* q) { return (unsigned)(unsigned long)q; }
__device__ __forceinline__ void glds16_asm(const void* gsrc, unsigned lds_dst) {
    unsigned keep; const unsigned dst = (unsigned)__builtin_amdgcn_readfirstlane((int)lds_dst);
    asm volatile("s_mov_b32 %0, m0\n\ts_mov_b32 m0, %2\n\ts_nop 0\n\tglobal_load_lds_dwordx4 %1, off\n\ts_mov_b32 m0, %0" : "=&s"(keep) : "v"(gsrc), "s"(dst) : "memory");
}
__device__ __forceinline__ void ds_read_b128_x2(u32x4& r0, u32x4& r1, unsigned a0, unsigned a1, const int off) {
    asm volatile("ds_read_b128 %0, %2 offset:%4\n\tds_read_b128 %1, %3 offset:%4\n\ts_waitcnt lgkmcnt(0)" : "=&v"(r0), "=&v"(r1) : "v"(a0), "v"(a1), "i"(off) : "memory");
}
__device__ __forceinline__ void glds16x2_s(const void* sbase, unsigned voff, unsigned lds_dst) {
    unsigned keep;
    asm volatile("s_mov_b32 %0, m0\n\ts_mov_b32 m0, %3\n\ts_nop 0\n\tglobal_load_lds_dwordx4 %1, %2\n\tglobal_load_lds_dwordx4 %1, %2 offset:1024\n\ts_mov_b32 m0, %0"
                 : "=&s"(keep) : "v"(voff), "s"(sbase), "s"(lds_dst) : "memory");
}
__device__ __forceinline__ void glds16_s2(const void* sa, const void* sb, unsigned voff, unsigned lds_a, unsigned lds_b) {
    unsigned keep;
    asm volatile("s_mov_b32 %0, m0\n\ts_mov_b32 m0, %4\n\ts_nop 0\n\tglobal_load_lds_dwordx4 %1, %2\n\ts_mov_b32 m0, %5\n\ts_nop 0\n\tglobal_load_lds_dwordx4 %1, %3\n\ts_mov_b32 m0, %0"
                 : "=&s"(keep) : "v"(voff), "s"(sa), "s"(sb), "s"(lds_a), "s"(lds_b) : "memory");
}
__device__ __forceinline__ void glds16_s4(const void* sbase, unsigned voff, unsigned lds_dst) {
    unsigned keep;
    asm volatile("s_mov_b32 %0, m0\n\ts_mov_b32 m0, %3\n\ts_nop 0\n\tglobal_load_lds_dwordx4 %1, %2\n\tglobal_load_lds_dwordx4 %1, %2 offset:1024\n\tglobal_load_lds_dwordx4 %1, %2 offset:2048\n\tglobal_load_lds_dwordx4 %1, %2 offset:3072\n\ts_mov_b32 m0, %0"
                 : "=&s"(keep) : "v"(voff), "s"(sbase), "s"(lds_dst) : "memory");
}
__device__ __forceinline__ void glds4_s2(const void* sa, const void* sb, unsigned voff, unsigned lds_a, unsigned lds_b) {
    unsigned keep;
    asm volatile("s_mov_b32 %0, m0\n\ts_mov_b32 m0, %4\n\ts_nop 0\n\tglobal_load_lds_dword %1, %2\n\ts_mov_b32 m0, %5\n\ts_nop 0\n\tglobal_load_lds_dword %1, %3\n\ts_mov_b32 m0, %0"
                 : "=&s"(keep) : "v"(voff), "s"(sa), "s"(sb), "s"(lds_a), "s"(lds_b) : "memory");
}
__device__ __forceinline__ void ds_read_tr16_b64_x8(u32x2 (&r)[8], const unsigned (&a)[8]) {
    asm volatile("ds_read_b64_tr_b16 %0, %8\n\tds_read_b64_tr_b16 %1, %9\n\tds_read_b64_tr_b16 %2, %10\n\tds_read_b64_tr_b16 %3, %11\n\t"
                 "ds_read_b64_tr_b16 %4, %12\n\tds_read_b64_tr_b16 %5, %13\n\tds_read_b64_tr_b16 %6, %14\n\tds_read_b64_tr_b16 %7, %15\n\ts_waitcnt lgkmcnt(0)"
                 : "=&v"(r[0]), "=&v"(r[1]), "=&v"(r[2]), "=&v"(r[3]), "=&v"(r[4]), "=&v"(r[5]), "=&v"(r[6]), "=&v"(r[7])
                 : "v"(a[0]), "v"(a[1]), "v"(a[2]), "v"(a[3]), "v"(a[4]), "v"(a[5]), "v"(a[6]), "v"(a[7]) : "memory");
}
__device__ __forceinline__ void ds_read_tr16_b64_x4(u32x2& r0, u32x2& r1, u32x2& r2, u32x2& r3, unsigned a0, unsigned a1, unsigned a2, unsigned a3) {
    asm volatile("ds_read_b64_tr_b16 %0, %4\n\tds_read_b64_tr_b16 %1, %5\n\tds_read_b64_tr_b16 %2, %6\n\tds_read_b64_tr_b16 %3, %7\n\ts_waitcnt lgkmcnt(0)"
                 : "=&v"(r0), "=&v"(r1), "=&v"(r2), "=&v"(r3) : "v"(a0), "v"(a1), "v"(a2), "v"(a3) : "memory");
}
constexpr int SC_K = 0, SC_Q = 16384, SC_T = 32768, SC_A = 40960, SC_S = 49152, SC_BUF = 49664;
constexpr int SC_VT = 2 * SC_BUF, SC_END = SC_VT + 2 * 4096;
constexpr unsigned SC_SPIN_CAP = 1u << 22;
#define SC_WAIT(flag, val) do { unsigned _sp = 0; while (*(flag) < (unsigned)(val) && ++_sp < SC_SPIN_CAP) __builtin_amdgcn_s_sleep(3); } while (0)
__device__ __forceinline__ void gdn_scan_issuer(KP p, int layer, int unit, LAS unsigned char* lds, int lane0, volatile LAS unsigned* f_dma, volatile LAS unsigned* f_done, unsigned fbase) {
    const int h = (unit >> 3) & 7, b = unit >> 6;
    const size_t mb = (size_t)b * SEQ;
    const bf16_t* rq = p->raw + h * 128; const bf16_t* rk = rq + (size_t)MTOK * 1024;
    const bf16_t* tab = (layer == 0 ? (const bf16_t*)p->out : p->ta) + (size_t)((b * 8 + h) * 256) * 8192;
    unsigned vo_kq[4];
#pragma unroll
    for (int j = 0; j < 4; ++j) vo_kq[j] = (unsigned)((lane0 >> 4) * 2048 + 16 * ((lane0 & 15) ^ ((4 * j + (lane0 >> 4)) & 15)));
    const unsigned vo_ta = (unsigned)((lane0 >> 3) * 128 + 16 * ((lane0 & 7) ^ ((lane0 >> 3) & 7))), vo_g = (unsigned)(lane0 * 32);
    const unsigned ldsS = (unsigned)__builtin_amdgcn_readfirstlane((int)lds_addr32(lds));
    for (int c = 0; c < 256; ++c) {
        if (c >= 2) SC_WAIT(f_done, fbase + c - 1);
        const size_t m0 = mb + 64 * (size_t)c; const unsigned l_ = ldsS + (c & 1) * SC_BUF;
        const char* sk = (const char*)(rk + m0 * 1024); const char* sq = (const char*)(rq + m0 * 1024);
#pragma unroll
        for (int i = 0; i < 16; ++i) glds16_s2(sk + i * 8192, sq + i * 8192, vo_kq[i & 3], l_ + SC_K + i * 1024, l_ + SC_Q + i * 1024);
        { const char* t = (const char*)(tab + (size_t)c * 8192);
          glds16_s4(t, vo_ta, l_ + SC_T); glds16_s4(t + 4096, vo_ta, l_ + SC_T + 4096); glds16_s4(t + 8192, vo_ta, l_ + SC_A); glds16_s4(t + 12288, vo_ta, l_ + SC_A + 4096); }
        glds4_s2(p->gg + m0 * 8 + h, p->beta + m0 * 8 + h, vo_g, l_ + SC_S, l_ + SC_S + 256);
        asm volatile("s_waitcnt vmcnt(0)" ::: "memory");
        *f_dma = fbase + (unsigned)c + 1u;
    }
}
__device__ __forceinline__ void gdn_scan_conv(KP p, int layer, int unit, LAS unsigned char* lds, int lane0, volatile LAS unsigned* f_dma, volatile LAS unsigned* f_vr, volatile LAS unsigned* f_done, unsigned fbase) {
    const int n = lane0 & 15, g = lane0 >> 4;
    const int cb = unit & 7, h = (unit >> 3) & 7, b = unit >> 6;
    const size_t mb = (size_t)b * SEQ;
    const bf16_t* rv = p->raw + (size_t)MTOK * 2048 + h * 128 + 16 * cb + n;
    const float* cw = p->conv_w + (size_t)layer * 4 * 3072 + 2048 + h * 128 + 16 * cb + n;
    const float wv0 = cw[0], wv1 = cw[3072], wv2 = cw[2 * 3072], wv3 = cw[3 * 3072];
    unsigned short xn[4][7];
    float pv[3] = {0.f, 0.f, 0.f};
#define SCV_LOAD(c) do { const size_t _m0 = mb + 64 * (size_t)(c); _Pragma("unroll") for (int _mt = 0; _mt < 4; ++_mt) _Pragma("unroll") for (int _k = 0; _k < 7; ++_k) { \
        const int _tok = 16 * _mt + 4 * g - 3 + _k; xn[_mt][_k] = rv[(_m0 + (size_t)(_tok < 0 ? 0 : _tok)) * 1024]; } } while (0)
    SCV_LOAD(0);
    for (int c = 0; c < 256; ++c) {
        float x[4][7];
#pragma unroll
        for (int mt = 0; mt < 4; ++mt)
#pragma unroll
            for (int k = 0; k < 7; ++k) x[mt][k] = bf2f(xn[mt][k]);
        asm volatile("" ::: "memory");
        if (c + 1 < 256) SCV_LOAD(c + 1);
#pragma unroll
        for (int k = 0; k < 3; ++k) if (4 * g - 3 + k < 0) x[0][k] = pv[k];
        f32x4 vt[4];
#pragma unroll
        for (int mt = 0; mt < 4; ++mt)
#pragma unroll
            for (int r = 0; r < 4; ++r) { const float y = wv0 * x[mt][r] + wv1 * x[mt][r + 1] + wv2 * x[mt][r + 2] + wv3 * x[mt][r + 3]; vt[mt][r] = y * sigmoidf_(y); }
#pragma unroll
        for (int k = 0; k < 3; ++k) pv[k] = __shfl(x[3][4 + k], 48 + n);
        if (c >= 2) SC_WAIT(f_done, fbase + c - 1);
        LAS unsigned char* slot = lds + SC_VT + (c & 1) * 4096;
#pragma unroll
        for (int mt = 0; mt < 4; ++mt) *(LAS f32x4*)(slot + ((mt * 4 + g) * 16 + n) * 16) = vt[mt];
        asm volatile("s_waitcnt lgkmcnt(0)" ::: "memory");
        SC_WAIT(f_dma, fbase + c + 1);
        *f_vr = fbase + (unsigned)c + 1u;
    }
#undef SCV_LOAD
}
__device__ __forceinline__ void gdn_scan_unit(KP p, int unit, LAS unsigned char* lds, int lane0, volatile LAS unsigned* f_vr, volatile LAS unsigned* f_done, unsigned fbase) {
    int lane = lane0; const int n = lane0 & 15, g = lane0 >> 4;
    const int cb = unit & 7, h = (unit >> 3) & 7, b = unit >> 6;
    const size_t mb = (size_t)b * SEQ;
    bf16_t* rv = p->raw + (size_t)MTOK * 2048 + h * 128 + 16 * cb;
    f32x4 S[8];
#pragma unroll
    for (int t = 0; t < 8; ++t) S[t] = (f32x4){0.f, 0.f, 0.f, 0.f};
    for (int c = 0; c < 256; ++c) {
        const int buf = c & 1; LAS unsigned char* L = lds + buf * SC_BUF;
        asm volatile("" : "+v"(lane));
        SC_WAIT(f_vr, fbase + c + 1);
        asm volatile("" ::: "memory");
        const float gcl = ((const LAS float*)(L + SC_S))[63];
        f32x4 vt[4];
        { const LAS unsigned char* slot = lds + SC_VT + buf * 4096;
#pragma unroll
          for (int mt = 0; mt < 4; ++mt) vt[mt] = *(const LAS f32x4*)(slot + ((mt * 4 + g) * 16 + n) * 16); }
        bf16x8 bS[4];
#pragma unroll
        for (int ks = 0; ks < 4; ++ks) { u32x4 w; w.x = cvt_pk_bf16(S[2 * ks][0], S[2 * ks][1]); w.y = cvt_pk_bf16(S[2 * ks][2], S[2 * ks][3]); w.z = cvt_pk_bf16(S[2 * ks + 1][0], S[2 * ks + 1][1]); w.w = cvt_pk_bf16(S[2 * ks + 1][2], S[2 * ks + 1][3]); bS[ks] = __builtin_bit_cast(bf16x8, w); }
#define SC_AFRAG128(IMG, mt, ks) ({ const int _row = 16 * (mt) + n; const LAS unsigned char* _b = L + (IMG) + _row * 256 + 8 * (g & 1); \
        const u32x2 _lo = *(const LAS u32x2*)(_b + 16 * ((4 * (ks) + (g >> 1)) ^ (_row & 15))), _hi = *(const LAS u32x2*)(_b + 16 * ((4 * (ks) + 2 + (g >> 1)) ^ (_row & 15))); \
        __builtin_bit_cast(bf16x8, (u32x4){_lo.x, _lo.y, _hi.x, _hi.y}); })
#define SC_AFRAG64(IMG, mt, ks) ({ const int _row = 16 * (mt) + n; const LAS unsigned char* _b = L + (IMG) + _row * 128 + 8 * (g & 1); \
        const u32x2 _lo = *(const LAS u32x2*)(_b + 16 * ((4 * (ks) + (g >> 1)) ^ (_row & 7))), _hi = *(const LAS u32x2*)(_b + 16 * ((4 * (ks) + 2 + (g >> 1)) ^ (_row & 7))); \
        __builtin_bit_cast(bf16x8, (u32x4){_lo.x, _lo.y, _hi.x, _hi.y}); })
        f32x4 KS[4], QS[4];
#pragma unroll
        for (int mt = 0; mt < 4; ++mt) { KS[mt] = (f32x4){0.f, 0.f, 0.f, 0.f}; QS[mt] = (f32x4){0.f, 0.f, 0.f, 0.f};
#pragma unroll
            for (int ks = 0; ks < 4; ++ks) { KS[mt] = __builtin_amdgcn_mfma_f32_16x16x32_bf16(SC_AFRAG128(SC_K, mt, ks), bS[ks], KS[mt], 0, 0, 0); QS[mt] = __builtin_amdgcn_mfma_f32_16x16x32_bf16(SC_AFRAG128(SC_Q, mt, ks), bS[ks], QS[mt], 0, 0, 0); } }
        f32x4 eg[4];
        bf16x8 bR[2];
        { f32x4 Rb[4];
#pragma unroll
          for (int mt = 0; mt < 4; ++mt) { const f32x4 gc4 = *(const LAS f32x4*)(L + SC_S + 4 * (16 * mt + 4 * g)), be4 = *(const LAS f32x4*)(L + SC_S + 256 + 4 * (16 * mt + 4 * g));
#pragma unroll
              for (int r = 0; r < 4; ++r) { eg[mt][r] = __expf(gc4[r]); Rb[mt][r] = be4[r] * (vt[mt][r] - eg[mt][r] * KS[mt][r]); QS[mt][r] *= eg[mt][r]; } }
#pragma unroll
          for (int ks = 0; ks < 2; ++ks) { u32x4 w; w.x = cvt_pk_bf16(Rb[2 * ks][0], Rb[2 * ks][1]); w.y = cvt_pk_bf16(Rb[2 * ks][2], Rb[2 * ks][3]); w.z = cvt_pk_bf16(Rb[2 * ks + 1][0], Rb[2 * ks + 1][1]); w.w = cvt_pk_bf16(Rb[2 * ks + 1][2], Rb[2 * ks + 1][3]); bR[ks] = __builtin_bit_cast(bf16x8, w); } }
        f32x4 vn[4];
#pragma unroll
        for (int mt = 0; mt < 4; ++mt) { vn[mt] = (f32x4){0.f, 0.f, 0.f, 0.f};
#pragma unroll
            for (int ks = 0; ks < 2; ++ks) vn[mt] = __builtin_amdgcn_mfma_f32_16x16x32_bf16(SC_AFRAG64(SC_T, mt, ks), bR[ks], vn[mt], 0, 0, 0); }
        bf16x8 bV[2], bVS[2];
#pragma unroll
        for (int ks = 0; ks < 2; ++ks) { u32x4 w; w.x = cvt_pk_bf16(vn[2 * ks][0], vn[2 * ks][1]); w.y = cvt_pk_bf16(vn[2 * ks][2], vn[2 * ks][3]); w.z = cvt_pk_bf16(vn[2 * ks + 1][0], vn[2 * ks + 1][1]); w.w = cvt_pk_bf16(vn[2 * ks + 1][2], vn[2 * ks + 1][3]); bV[ks] = __builtin_bit_cast(bf16x8, w);
            const f32x4 ga = *(const LAS f32x4*)(L + SC_S + 4 * (32 * ks + 4 * g)), gb2 = *(const LAS f32x4*)(L + SC_S + 4 * (32 * ks + 16 + 4 * g));
            f32x4 ea, eb;
#pragma unroll
            for (int r = 0; r < 4; ++r) { ea[r] = vn[2 * ks][r] * __expf(gcl - ga[r]); eb[r] = vn[2 * ks + 1][r] * __expf(gcl - gb2[r]); }
            u32x4 z; z.x = cvt_pk_bf16(ea[0], ea[1]); z.y = cvt_pk_bf16(ea[2], ea[3]); z.z = cvt_pk_bf16(eb[0], eb[1]); z.w = cvt_pk_bf16(eb[2], eb[3]); bVS[ks] = __builtin_bit_cast(bf16x8, z); }
        { const size_t m0 = mb + 64 * (size_t)c;
#pragma unroll
          for (int mt = 0; mt < 4; ++mt) {
#pragma unroll
              for (int ks = 0; ks < 2; ++ks) QS[mt] = __builtin_amdgcn_mfma_f32_16x16x32_bf16(SC_AFRAG64(SC_A, mt, ks), bV[ks], QS[mt], 0, 0, 0);
#pragma unroll
              for (int r = 0; r < 4; ++r) rv[(m0 + 16 * mt + 4 * g + r) * 1024 + n] = f2bf(QS[mt][r]); } }
        { const float egl = __expf(gcl); const int q4 = (lane & 15) >> 2, p4 = lane & 3; const unsigned kbase = lds_addr32(L + SC_K) + 8 * (p4 & 1);
#pragma unroll
          for (int t = 0; t < 8; t += 2) {
              u32x2 f[8]; unsigned fa[8];
#pragma unroll
              for (int tt = 0; tt < 2; ++tt)
#pragma unroll
                  for (int ks = 0; ks < 2; ++ks)
#pragma unroll
                      for (int u = 0; u < 2; ++u) { const int row = 32 * ks + 16 * u + 4 * g + q4; fa[tt * 4 + ks * 2 + u] = kbase + row * 256 + 16 * ((2 * (t + tt) + (p4 >> 1)) ^ (row & 15)); }
              ds_read_tr16_b64_x8(f, fa);
#pragma unroll
              for (int tt = 0; tt < 2; ++tt) {
                  S[t + tt] = S[t + tt] * egl;
#pragma unroll
                  for (int ks = 0; ks < 2; ++ks) S[t + tt] = __builtin_amdgcn_mfma_f32_16x16x32_bf16(__builtin_bit_cast(bf16x8, (u32x4){f[tt * 4 + ks * 2].x, f[tt * 4 + ks * 2].y, f[tt * 4 + ks * 2 + 1].x, f[tt * 4 + ks * 2 + 1].y}), bVS[ks], S[t + tt], 0, 0, 0);
              }
          } }
        asm volatile("s_waitcnt lgkmcnt(0)" ::: "memory");
        *f_done = fbase + (unsigned)c + 1u;
    }
#undef SC_AFRAG128
#undef SC_AFRAG64
}


constexpr int SA_LDS_WAVE = 16384;
template <bool DB> __device__ __forceinline__ void phase_sparse_attn(KP p, unsigned* counter, unsigned qx, LAS unsigned char* wl, int lane) {
    const int n = lane & 15, gq = lane >> 4, q4 = n >> 2, p4 = n & 3;
    constexpr unsigned NITEMS = (unsigned)(MTOK * 2);
    unsigned raw = 0;
    if (lane == 0) raw = __hip_atomic_fetch_add(counter, 1u, __ATOMIC_RELAXED, __HIP_MEMORY_SCOPE_AGENT);
    unsigned it = (unsigned)__builtin_amdgcn_readfirstlane((int)raw) * 32u + qx;
    if (it >= NITEMS) return;
    if (lane == 0) raw = __hip_atomic_fetch_add(counter, 1u, __ATOMIC_RELAXED, __HIP_MEMORY_SCOPE_AGENT);
    const bf16_t* selrow; const bf16_t* kbase; const bf16_t* vbase; bf16_t* qrow;
#define SA_DECODE(IT) do { const int _bg = (int)((IT) / SEQ), _t = (int)((IT) % SEQ), _b = _bg >> 1, _gk = _bg & 1; const size_t _m = (size_t)_b * SEQ + _t; \
        selrow = p->sel + _m * TOPK; kbase = p->kb + (size_t)_b * SEQ * 256 + _gk * 128 + 8 * gq; vbase = p->vb + (size_t)_b * SEQ * 256 + _gk * 128; qrow = p->qb + _m * 1024 + _gk * 512; } while (0)
#define SA_ISSUE_V(c, BUF) do { LAS unsigned char* _d = wl + (BUF) * 8192; \
        _Pragma("unroll") for (int _i = 0; _i < 8; ++_i) { const int _r = 4 * _i + gq; unsigned _s = selrow[32 * (c) + _r]; _s = (_s == 0xFFFFu) ? 0u : _s; \
            __builtin_amdgcn_global_load_lds((const unsigned*)(vbase + (size_t)_s * 256 + 8 * (n ^ (_r & 15))), (LAS unsigned*)(_d + _i * 1024), 16, 0, 0); } } while (0)
#define SA_LOAD_SKQ() do { _Pragma("unroll") for (int _kt = 0; _kt < 16; _kt += 2) { unsigned _t0 = selrow[16 * _kt + n], _t1 = selrow[16 * _kt + 16 + n]; _t0 = (_t0 == 0xFFFFu) ? 0u : _t0; _t1 = (_t1 == 0xFFFFu) ? 0u : _t1; sk[_kt >> 1] = _t0 | (_t1 << 16); } \
        _Pragma("unroll") for (int _ks = 0; _ks < 4; ++_ks) { u32x4 _w = (u32x4){0u, 0u, 0u, 0u}; if (n < 4) _w = __builtin_nontemporal_load((const u32x4*)(qrow + n * 128 + 32 * _ks + 8 * gq)); bQ[_ks] = __builtin_bit_cast(bf16x8, _w); } } while (0)
#define SA_LOADK(kt) do { const bf16_t* _kr = kbase + (size_t)(((kt) & 1) ? (sk[(kt) >> 1] >> 16) : (sk[(kt) >> 1] & 0xffffu)) * 256; _Pragma("unroll") for (int _ks = 0; _ks < 4; ++_ks) kf[(kt) % 3][_ks] = *(const bf16x8*)(_kr + 32 * _ks); } while (0)
#define SA_FENCE() asm volatile("" ::: "memory")
    unsigned sk[8]; bf16x8 bQ[4]; bf16x8 kf[3][4];
    SA_DECODE(it);
    SA_ISSUE_V(0, 0); if (DB) SA_ISSUE_V(1, 1);
    SA_FENCE(); SA_LOAD_SKQ(); SA_LOADK(0); SA_LOADK(1); SA_LOADK(2); SA_FENCE();
    for (;;) {
        f32x4 ST[16];
        float mx = -INFINITY;
#pragma unroll
        for (int kt = 0; kt < 16; ++kt) {
            f32x4 acc = (f32x4){0.f, 0.f, 0.f, 0.f};
#pragma unroll
            for (int ks = 0; ks < 4; ++ks) acc = __builtin_amdgcn_mfma_f32_16x16x32_bf16(kf[kt % 3][ks], bQ[ks], acc, 0, 0, 0);
            if (kt + 3 < 16) SA_LOADK(kt + 3);
            const u32x2 sv = *(const u32x2*)(selrow + 16 * kt + 4 * gq);
            const bool v0 = (sv.x & 0xffffu) != 0xffffu, v1 = (sv.x >> 16) != 0xffffu, v2 = (sv.y & 0xffffu) != 0xffffu, v3 = (sv.y >> 16) != 0xffffu;
            acc[0] = v0 ? acc[0] : -INFINITY; acc[1] = v1 ? acc[1] : -INFINITY; acc[2] = v2 ? acc[2] : -INFINITY; acc[3] = v3 ? acc[3] : -INFINITY;
            ST[kt] = acc; mx = fmaxf(fmaxf(mx, fmaxf(acc[0], acc[1])), fmaxf(acc[2], acc[3]));
        }
        mx = fmaxf(mx, __shfl_xor(mx, 16)); mx = fmaxf(mx, __shfl_xor(mx, 32));
        float sum = 0.f;
#pragma unroll
        for (int kt = 0; kt < 16; ++kt)
#pragma unroll
            for (int r = 0; r < 4; ++r) { const float e = __expf(ST[kt][r] - mx); ST[kt][r] = e; sum += e; }
        sum += __shfl_xor(sum, 16); sum += __shfl_xor(sum, 32);
        const float inv = 1.0f / sum;
        bf16_t* const qcur = qrow; const bf16_t* const selcur = selrow; const bf16_t* const vcur = vbase;
        const unsigned nxt = (unsigned)__builtin_amdgcn_readfirstlane((int)raw) * 32u + qx;
        const bool valid = nxt < NITEMS;
        if (valid) { if (lane == 0) raw = __hip_atomic_fetch_add(counter, 1u, __ATOMIC_RELAXED, __HIP_MEMORY_SCOPE_AGENT); }
        SA_FENCE();
        if (valid) { SA_DECODE(nxt); SA_LOAD_SKQ(); }
        SA_FENCE();
        f32x4 OT[8];
#pragma unroll
        for (int dt = 0; dt < 8; ++dt) OT[dt] = (f32x4){0.f, 0.f, 0.f, 0.f};
#pragma unroll
        for (int c = 0; c < 8; ++c) {
            if (DB) { if (c <= 1) { if (valid) asm volatile("s_waitcnt vmcnt(21)" ::: "memory"); else asm volatile("s_waitcnt vmcnt(0)" ::: "memory"); }
                      else if (c <= 4) asm volatile("s_waitcnt vmcnt(8)" ::: "memory");
                      else if (c <= 6) { if (valid) asm volatile("s_waitcnt vmcnt(20)" ::: "memory"); else asm volatile("s_waitcnt vmcnt(8)" ::: "memory"); }
                      else { if (valid) asm volatile("s_waitcnt vmcnt(8)" ::: "memory"); else asm volatile("s_waitcnt vmcnt(0)" ::: "memory"); } }
            else { if (c == 5 && valid) asm volatile("s_waitcnt vmcnt(12)" ::: "memory"); else asm volatile("s_waitcnt vmcnt(0)" ::: "memory"); }
            u32x4 w; w.x = cvt_pk_bf16(ST[2 * c][0], ST[2 * c][1]); w.y = cvt_pk_bf16(ST[2 * c][2], ST[2 * c][3]); w.z = cvt_pk_bf16(ST[2 * c + 1][0], ST[2 * c + 1][1]); w.w = cvt_pk_bf16(ST[2 * c + 1][2], ST[2 * c + 1][3]);
            const bf16x8 bP = __builtin_bit_cast(bf16x8, w);
            const unsigned vb0 = lds_addr32(wl + (DB ? (c & 1) * 8192 : 0)) + 8 * (p4 & 1);
#pragma unroll
            for (int dt = 0; dt < 8; dt += 2) {
                u32x2 f00, f01, f10, f11;
                const int r0 = 4 * gq + q4, r1 = 16 + 4 * gq + q4;
                ds_read_tr16_b64_x4(f00, f01, f10, f11,
                    vb0 + r0 * 256 + 16 * ((2 * dt + (p4 >> 1)) ^ (r0 & 15)), vb0 + r1 * 256 + 16 * ((2 * dt + (p4 >> 1)) ^ (r1 & 15)),
                    vb0 + r0 * 256 + 16 * ((2 * dt + 2 + (p4 >> 1)) ^ (r0 & 15)), vb0 + r1 * 256 + 16 * ((2 * dt + 2 + (p4 >> 1)) ^ (r1 & 15)));
                OT[dt] = __builtin_amdgcn_mfma_f32_16x16x32_bf16(__builtin_bit_cast(bf16x8, (u32x4){f00.x, f00.y, f01.x, f01.y}), bP, OT[dt], 0, 0, 0);
                OT[dt + 1] = __builtin_amdgcn_mfma_f32_16x16x32_bf16(__builtin_bit_cast(bf16x8, (u32x4){f10.x, f10.y, f11.x, f11.y}), bP, OT[dt + 1], 0, 0, 0);
            }
            SA_FENCE();
            { const bf16_t* const seln = selrow; const bf16_t* const vn_ = vbase;
              if (DB) { if (c + 2 < 8) { selrow = selcur; vbase = vcur; SA_ISSUE_V(c + 2, c & 1); selrow = seln; vbase = vn_; } else if (valid) SA_ISSUE_V(c - 6, c & 1); }
              else    { if (c + 1 < 8) { selrow = selcur; vbase = vcur; SA_ISSUE_V(c + 1, 0); selrow = seln; vbase = vn_; } else if (valid) SA_ISSUE_V(0, 0); } }
            SA_FENCE();
            if (c == 4 && valid) { SA_LOADK(0); SA_LOADK(1); SA_LOADK(2); SA_FENCE(); }
        }
        if (n < 4) {
#pragma unroll
            for (int dt = 0; dt < 8; ++dt) { u32x2 w; w.x = cvt_pk_bf16(OT[dt][0] * inv, OT[dt][1] * inv); w.y = cvt_pk_bf16(OT[dt][2] * inv, OT[dt][3] * inv); __builtin_nontemporal_store(w, (u32x2*)(qcur + n * 128 + 16 * dt + 4 * gq)); }
        }
        if (!valid) break;
        it = nxt;
    }
#undef SA_DECODE
#undef SA_ISSUE_V
#undef SA_LOAD_SKQ
#undef SA_LOADK
#undef SA_FENCE
}

#define SEL_DPP(v, ctrl, rowmask) ((unsigned)__builtin_amdgcn_update_dpp(0, (int)(v), (ctrl), (rowmask), 0xf, false))
__device__ __forceinline__ unsigned row_incl_scan(unsigned v) { v += SEL_DPP(v, 0x111, 0xf); v += SEL_DPP(v, 0x112, 0xf); v += SEL_DPP(v, 0x114, 0xf); v += SEL_DPP(v, 0x118, 0xf); return v; }
__device__ __forceinline__ unsigned wave_incl_scan(unsigned v) { v = row_incl_scan(v); v += SEL_DPP(v, 0x142, 0xa); v += SEL_DPP(v, 0x143, 0xc); return v; }
__device__ __forceinline__ unsigned row_min_all(unsigned v) { v = min(v, SEL_DPP(v, 0xB1, 0xf)); v = min(v, SEL_DPP(v, 0x4E, 0xf)); v = min(v, SEL_DPP(v, 0x141, 0xf)); v = min(v, SEL_DPP(v, 0x140, 0xf)); return v; }
__device__ __forceinline__ unsigned row_max_all(unsigned v) { v = max(v, SEL_DPP(v, 0xB1, 0xf)); v = max(v, SEL_DPP(v, 0x4E, 0xf)); v = max(v, SEL_DPP(v, 0x141, 0xf)); v = max(v, SEL_DPP(v, 0x140, 0xf)); return v; }
template <int FB> __device__ __forceinline__ unsigned sel_bin(unsigned d) { return ((d & ((1u << FB) - 1u)) << 6) | (d >> FB); }
template <int FB> __device__ __forceinline__ void sel_find_bin(const LAS unsigned* h, unsigned need, LAS unsigned* out, LAS unsigned* out2, LAS unsigned* tie, int lane) {
    const int rl = 63 - lane;
    unsigned c = 0;
#pragma unroll
    for (int k = 0; k < (1 << FB); ++k) c += h[k * 64 + rl];
    const unsigned incl = wave_incl_scan(c);
    const unsigned above = incl - c;
    const unsigned long long m = __ballot(above < need && need <= incl);
    if (m == 0ull) return;
    const int hl = __builtin_ctzll(m);
    const unsigned hg = (unsigned)(63 - hl);
    const unsigned need2 = need - (unsigned)__builtin_amdgcn_readlane((int)above, hl);
    const int fb = (1 << FB) - 1 - lane;
    const unsigned f = lane < (1 << FB) ? h[fb * 64 + hg] : 0u;
    const unsigned incl2 = wave_incl_scan(f);
    const unsigned above2 = incl2 - f;
    if (above2 < need2 && need2 <= incl2) { out[0] = (hg << FB) + (unsigned)fb; out[1] = need2 - above2; if (out2) *out2 = f; if (tie && f > need2 - above2) *tie = 1u; }
}
#define SEL_BIN(d) sel_bin<6>(d)
__device__ __forceinline__ void phase_dsa_select(KP p, LAS unsigned char* lds) {
    const int tid = tid_opaque(), lane0 = tid & 63, wid0 = __builtin_amdgcn_readfirstlane(tid >> 6);
    LAS unsigned* hist = (LAS unsigned*)lds;
    LAS unsigned short* cntG = (LAS unsigned short*)(lds + 65536);
    LAS unsigned short* cntE = cntG + 4096;
    LAS unsigned* ctl = (LAS unsigned*)(lds + 131072);
    const int xcd = blockIdx.x & 7, b = xcd >> 2, lb = (blockIdx.x >> 3) * 4 + (xcd & 3);
    const int nlb = (gridDim.x >> 3) * 4;
    for (int gi = lb; gi < SEQ / 4; gi += nlb) {
        const int t0 = 4 * gi; const size_t mq0 = (size_t)b * SEQ + t0;
        int lane = lane0, wid = wid0; asm volatile("" : "+v"(lane), "+s"(wid));
        const int n = lane & 15, gq = lane >> 4;
        if (t0 + 4 <= TOPK) {
            const int tidp = wid * 64 + lane; const int q = tidp >> 7, i = (tidp & 127) * 2, t = t0 + q;
            *(unsigned*)(p->sel + (mq0 + q) * TOPK + i) = (unsigned)(i <= t ? i : 0xFFFF) | ((unsigned)(i + 1 <= t ? i + 1 : 0xFFFF) << 16);
            continue;
        }
        const int NT = (t0 + 3) / 16 + 1;
        bf16x8 aq[2];
#pragma unroll
        for (int ks = 0; ks < 2; ++ks) aq[ks] = *(const bf16x8*)(p->qib + (mq0 + (n >> 2)) * 256 + (n & 3) * 64 + 32 * ks + 8 * gq);
        const f32x4 w4 = *(const f32x4*)(p->wi + (mq0 + gq) * 4);
        const int tq = t0 + gq;
        const int nj = (NT - wid + 7) >> 3;
        const int NB = (nj + 1) >> 1;
        LAS unsigned char* ring = lds + wid * 16384; const unsigned ring32 = lds_addr32(ring);
        const bf16_t* kib0 = p->kib + (size_t)b * SEQ * 64;
        const int dk = lane >> 3, dc = (lane & 7);
        const unsigned dvoff = (unsigned)(dk * 128 + 16 * (dc ^ (dk & 7)));
        const unsigned ringS = (unsigned)__builtin_amdgcn_readfirstlane((int)ring32);
#define SEL_ISSUE(blk) do { _Pragma("unroll") for (int _jj = 0; _jj < 2; ++_jj) { int _tile = 8 * (2 * (blk) + _jj) + wid; _tile = _tile < NT ? _tile : NT - 1; \
            glds16x2_s(kib0 + (size_t)_tile * 1024, dvoff, ringS + (((blk) & 3) * 2 + _jj) * 2048); } } while (0)
        unsigned mk[128];
        unsigned m1 = 0u, m2 = 0u;
        SEL_ISSUE(0); SEL_ISSUE(1); SEL_ISSUE(2);
        asm volatile("" :: "v"(aq[0]), "v"(aq[1]), "v"(w4));
        const unsigned ra0 = ring32 + n * 128 + 16 * (gq ^ (n & 7)), ra1 = ring32 + n * 128 + 16 * ((4 + gq) ^ (n & 7));
#pragma unroll
        for (int blk = 0; blk < 64; ++blk) {
            if (blk < NB) {
                SEL_ISSUE(blk + 3);
                asm volatile("s_waitcnt vmcnt(12)" ::: "memory");
#pragma unroll
                for (int jj = 0; jj < 2; ++jj) { const int tile = 8 * (2 * blk + jj) + wid;
                    u32x4 k0, k1; ds_read_b128_x2(k0, k1, ra0, ra1, ((blk & 3) * 2 + jj) * 2048);
                    f32x4 acc = __builtin_amdgcn_mfma_f32_16x16x32_bf16(aq[0], __builtin_bit_cast(bf16x8, k0), (f32x4){0.f, 0.f, 0.f, 0.f}, 0, 0, 0);
                    acc = __builtin_amdgcn_mfma_f32_16x16x32_bf16(aq[1], __builtin_bit_cast(bf16x8, k1), acc, 0, 0, 0);
                    float sc = w4[0] * relu_(acc[0]) + w4[1] * relu_(acc[1]) + w4[2] * relu_(acc[2]) + w4[3] * relu_(acc[3]);
                    sc += 0.0f;
                    const unsigned bits = __float_as_uint(sc); const unsigned mono = bits ^ ((bits >> 31) ? 0xFFFFFFFFu : 0x80000000u);
                    const unsigned kv = (16 * tile + n <= tq) ? mono : 0u; mk[2 * blk + jj] = kv; m2 = max(m2, min(m1, kv)); m1 = max(m1, kv); }
            } else { mk[2 * blk] = 0u; mk[2 * blk + 1] = 0u; }
        }
#undef SEL_ISSUE
        asm volatile("s_waitcnt vmcnt(0)" ::: "memory");
        __syncthreads();
        int lane_b = 16 * gq + n, wid_b = __builtin_amdgcn_readfirstlane(wid); asm volatile("" : "+v"(lane_b), "+s"(wid_b));
        const int tid_b = wid_b * 64 + lane_b;
        LAS unsigned* hq = hist + gq * 4096;
#define SEL_ZERO_HIST() do { const u32x4 z = (u32x4){0u, 0u, 0u, 0u}; _Pragma("unroll") for (int i = 0; i < 8; ++i) *(LAS u32x4*)(hist + (i * NTHREADS + tid_b) * 4) = z; } while (0)
        unsigned lbound;
        {
          m2 = row_min_all(m2); m1 = row_max_all(m1);
          if (n == 0) { ctl[8 + wid * 4 + gq] = m2; ctl[64 + wid * 4 + gq] = m1; }
          if (tid_b < 24) ctl[40 + tid_b] = 0u;
          { const u32x4 z = (u32x4){0u, 0u, 0u, 0u};
#pragma unroll
            for (int i = 0; i < 8; ++i) *(LAS u32x4*)(lds + 65536 + (i * NTHREADS + tid_b) * 16) = z;
            *(LAS u32x4*)(lds + 133632 + tid_b * 16) = z; }
          __syncthreads();
          unsigned lb2 = ctl[8 + gq];
#pragma unroll
          for (int w = 1; w < NWAVES; ++w) lb2 = min(lb2, ctl[8 + w * 4 + gq]);
          lbound = lb2; }
        constexpr int LCAP = 2048;
        LAS unsigned* lc = ctl + 40; LAS unsigned* tief = ctl + 48; LAS unsigned short* selt = (LAS unsigned short*)(lds + 131584);
        { const unsigned lb1 = max(lbound, 1u);
          unsigned cnt = 0u;
#pragma unroll
          for (int jb = 0; jb < 16; ++jb) { if (8 * jb < nj) {
#pragma unroll
              for (int jj = 0; jj < 8; ++jj) cnt += (mk[8 * jb + jj] >= lb1) ? 1u : 0u; } }
          const unsigned incl = row_incl_scan(cnt);
          unsigned base = 0u;
          if (n == 15) base = __hip_atomic_fetch_add(lc + gq, incl, __ATOMIC_RELAXED, __HIP_MEMORY_SCOPE_WORKGROUP);
          base = row_max_all(base);
          const unsigned lbw = (base + incl > (unsigned)LCAP) ? 0xFFFFFFFFu : lb1;
          LAS u32x2* wp = (LAS u32x2*)(lds + gq * (LCAP * 8)) + (base + incl - cnt);
#pragma unroll
          for (int jb = 0; jb < 16; ++jb) { if (8 * jb < nj) {
#pragma unroll
              for (int jj = 0; jj < 8; ++jj) { const int j = 8 * jb + jj; const unsigned v = mk[j];
                  if (v >= lbw) { unsigned vv = v; asm volatile("" : "+v"(vv));
                      *wp = (u32x2){vv, (unsigned)(16 * (8 * j + wid) + n)}; ++wp; } }
              asm volatile("" ::: "memory"); } } }
        __syncthreads();
        const bool overflow = (lc[0] > (unsigned)LCAP) || (lc[1] > (unsigned)LCAP) || (lc[2] > (unsigned)LCAP) || (lc[3] > (unsigned)LCAP);
        if (!overflow) {
            int lane_c = lane_b, wid_c = __builtin_amdgcn_readfirstlane(wid_b); asm volatile("" : "+v"(lane_c), "+s"(wid_c));
            const int q = wid_c >> 1, r = ((wid_c & 1) << 6) | lane_c; const unsigned nq = (unsigned)__builtin_amdgcn_readfirstlane((int)lc[q]);
            LAS unsigned* ha = (LAS unsigned*)(lds + 65536) + q * 2048; LAS unsigned* hb = (LAS unsigned*)(lds + 98304) + q * 2048;
            u32x2 ent[16];
            const bool big = nq > 1024u;
#define SEL_FOR_ENT(...) do { _Pragma("unroll") for (int i = 0; i < 8; ++i) { __VA_ARGS__ } if (big) { _Pragma("unroll") for (int i = 8; i < 16; ++i) { __VA_ARGS__ } } } while (0)
            { const LAS unsigned char* lq = lds + q * (LCAP * 8);
#pragma unroll
              for (int i = 8; i < 16; ++i) ent[i] = (u32x2){0u, 0u};
              SEL_FOR_ENT(const u32x2 t = *(const LAS u32x2*)(lq + (128 * i + r) * 8); ent[i].x = ((unsigned)(128 * i + r) < nq) ? t.x : 0u; ent[i].y = t.y;); }
            unsigned lbq = ctl[8 + q], vmax = ctl[64 + q];
#pragma unroll
            for (int w = 1; w < NWAVES; ++w) { lbq = min(lbq, ctl[8 + w * 4 + q]); vmax = max(vmax, ctl[64 + w * 4 + q]); }
            lbq = max(lbq, 1u) - 1u;
            SEL_FOR_ENT(ent[i].x = (ent[i].x != 0u) ? ent[i].x - lbq : 0u;);
            const int nbits = 32 - __builtin_clz(vmax - lbq);
            const int s0 = max(nbits - 11, 0), s1 = max(s0 - 11, 0);
            unsigned pref = 0u, need = (unsigned)TOPK;
            SEL_FOR_ENT(const unsigned v = ent[i].x; if (v != 0u) __hip_atomic_fetch_add(ha + sel_bin<5>(v >> s0), 1u, __ATOMIC_RELAXED, __HIP_MEMORY_SCOPE_WORKGROUP););
            __syncthreads();
            if ((wid & 1) == 0) sel_find_bin<5>(ha, need, ctl + 2 * q, ctl + 52 + q, (LAS unsigned*)nullptr, lane);
            __syncthreads();
            pref = ctl[2 * q]; need = ctl[2 * q + 1];
#pragma unroll
            for (int k = 0; k < 4; ++k) *(LAS u32x4*)(ha + (k * 128 + r) * 4) = (u32x4){0u, 0u, 0u, 0u};
            SEL_FOR_ENT(const unsigned v = ent[i].x; if (v != 0u && (v >> s0) == pref) __hip_atomic_fetch_add(hb + sel_bin<5>((v >> s1) & ((1u << (s0 - s1)) - 1u)), 1u, __ATOMIC_RELAXED, __HIP_MEMORY_SCOPE_WORKGROUP););
            __syncthreads();
            if ((wid & 1) == 0) sel_find_bin<5>(hb, need, ctl + 2 * q, ctl + 52 + q, (LAS unsigned*)nullptr, lane);
            __syncthreads();
            pref = (pref << (s0 - s1)) | ctl[2 * q]; need = ctl[2 * q + 1];
            SEL_FOR_ENT(const unsigned v = ent[i].x; if (v != 0u && (v >> s1) == pref) __hip_atomic_fetch_add(ha + sel_bin<4>(v & ((1u << s1) - 1u)), 1u, __ATOMIC_RELAXED, __HIP_MEMORY_SCOPE_WORKGROUP););
            __syncthreads();
            if ((wid & 1) == 0) sel_find_bin<4>(ha, need, ctl + 2 * q, ctl + 52 + q, tief, lane);
            __syncthreads();
            pref = (pref << s1) | ctl[2 * q]; need = ctl[2 * q + 1];
            const unsigned tau = pref, needE = need, nE = ctl[52 + q];
            unsigned thrR = 0u;
            if (*tief) {
                unsigned prefR = 0u, needR = needE;
#pragma unroll
                for (int lvl = 0; lvl < 2; ++lvl) {
                    if (r < 32) *(LAS u32x4*)(ha + r * 4) = (u32x4){0u, 0u, 0u, 0u};
                    __syncthreads();
                    SEL_FOR_ENT(if (ent[i].x == tau) { const unsigned kr = 16383u - ent[i].y;
                        if (lvl == 0 || (kr >> 7) == prefR) __hip_atomic_fetch_add(ha + sel_bin<1>(lvl == 0 ? (kr >> 7) : (kr & 127u)), 1u, __ATOMIC_RELAXED, __HIP_MEMORY_SCOPE_WORKGROUP); });
                    __syncthreads();
                    if ((wid & 1) == 0) sel_find_bin<1>(ha, needR, ctl + 2 * q, (LAS unsigned*)nullptr, (LAS unsigned*)nullptr, lane);
                    __syncthreads();
                    prefR = (prefR << 7) | ctl[2 * q]; needR = ctl[2 * q + 1];
                }
                thrR = (nE > needE) ? prefR : 0u;
            }
            LAS unsigned* bm = (LAS unsigned*)(lds + 133632) + q * 512;
            SEL_FOR_ENT(const unsigned v = ent[i].x; const unsigned ix = ent[i].y;
                if (v > tau || (v == tau && (16383u - ix) >= thrR)) __hip_atomic_fetch_or(bm + (ix >> 5), 1u << (ix & 31u), __ATOMIC_RELAXED, __HIP_MEMORY_SCOPE_WORKGROUP););
            __syncthreads();
            { const u32x4 w = *(const LAS u32x4*)(bm + 4 * r);
              const unsigned c = (unsigned)(__popc(w.x) + __popc(w.y) + __popc(w.z) + __popc(w.w));
              const unsigned incl = wave_incl_scan(c);
              if (lane_c == 63) ctl[56 + wid_c] = incl;
              __syncthreads();
              unsigned pos = incl - c + ((wid_c & 1) ? ctl[56 + wid_c - 1] : 0u);
              LAS unsigned short* st = selt + q * TOPK;
#pragma unroll
              for (int k = 0; k < 4; ++k) { unsigned ww = w[k];
                  while (ww) { const unsigned bpos = (unsigned)__builtin_ctz(ww); if (pos < (unsigned)TOPK) st[pos] = (unsigned short)(128 * r + 32 * k + bpos); ++pos; ww &= ww - 1u; } }
              __syncthreads();
              *(unsigned*)(p->sel + (mq0 + q) * TOPK + 2 * r) = *(const LAS unsigned*)(st + 2 * r); }
#undef SEL_FOR_ENT
            continue;
        }
        SEL_ZERO_HIST();
        __syncthreads();
        unsigned pref = 0u, need = (unsigned)TOPK;
#pragma unroll
        for (int lvl = 0; lvl < 3; ++lvl) {
            const int sh = lvl == 0 ? 20 : (lvl == 1 ? 8 : 0), nb = lvl == 2 ? 8 : 12;
            if (lvl > 0) { __syncthreads(); SEL_ZERO_HIST(); __syncthreads(); }
#pragma unroll
            for (int jb = 0; jb < 16; ++jb) { if (8 * jb < nj) {
#pragma unroll
                for (int jj = 0; jj < 8; ++jj) { const unsigned v = mk[8 * jb + jj];
                    const bool in = (lvl == 0) ? (v != 0u && v >= lbound) : ((v >> (sh + nb)) == pref);
                    if (in) { const unsigned d = (v >> sh) & ((1u << nb) - 1u); __hip_atomic_fetch_add(hq + SEL_BIN(d), 1u, __ATOMIC_RELAXED, __HIP_MEMORY_SCOPE_WORKGROUP); } }
                asm volatile("" ::: "memory"); } }
            __syncthreads();
            if (wid < 4) { const unsigned nq = (unsigned)__builtin_amdgcn_readlane((int)need, 16 * wid);
                sel_find_bin<6>(hist + wid * 4096, nq, ctl + 2 * wid, (LAS unsigned*)nullptr, (LAS unsigned*)nullptr, lane); }
            __syncthreads();
            pref = (pref << nb) | ctl[2 * gq]; need = ctl[2 * gq + 1];
        }
#undef SEL_ZERO_HIST
        const unsigned tau = pref, needE = need;
        { const u32x4 z = (u32x4){0u, 0u, 0u, 0u}; *(LAS u32x4*)(cntG + tid_b * 8) = z; *(LAS u32x4*)(cntG + 4096 + tid_b * 8) = z; }
        __syncthreads();
#pragma unroll
        for (int jb = 0; jb < 16; ++jb) { if (8 * jb < nj) {
#pragma unroll
            for (int jj = 0; jj < 8; ++jj) { const int j = 8 * jb + jj; const unsigned v = mk[j];
                const unsigned long long bg = __ballot(v > tau), be = __ballot(v == tau);
                if ((bg | be) && n == 0) { const int tile = 8 * j + wid; cntG[gq * 1024 + tile] = (unsigned short)__popc((unsigned)(bg >> (16 * gq)) & 0xffffu); cntE[gq * 1024 + tile] = (unsigned short)__popc((unsigned)(be >> (16 * gq)) & 0xffffu); } }
            asm volatile("" ::: "memory"); } }
        __syncthreads();
        { LAS unsigned short* cp = (wid < 4 ? cntG : cntE) + (wid & 3) * 1024 + 16 * lane;
          const u32x4 a = *(const LAS u32x4*)cp, c2 = *(const LAS u32x4*)(cp + 8);
          unsigned v[16] = {a.x & 0xffffu, a.x >> 16, a.y & 0xffffu, a.y >> 16, a.z & 0xffffu, a.z >> 16, a.w & 0xffffu, a.w >> 16, c2.x & 0xffffu, c2.x >> 16, c2.y & 0xffffu, c2.y >> 16, c2.z & 0xffffu, c2.z >> 16, c2.w & 0xffffu, c2.w >> 16};
          unsigned tot = 0;
#pragma unroll
          for (int i = 0; i < 16; ++i) { const unsigned t = v[i]; v[i] = tot; tot += t; }
          const unsigned incl = wave_incl_scan(tot);
          const unsigned base = incl - tot;
          u32x4 o0, o1;
          o0.x = (v[0] + base) | ((v[1] + base) << 16); o0.y = (v[2] + base) | ((v[3] + base) << 16); o0.z = (v[4] + base) | ((v[5] + base) << 16); o0.w = (v[6] + base) | ((v[7] + base) << 16);
          o1.x = (v[8] + base) | ((v[9] + base) << 16); o1.y = (v[10] + base) | ((v[11] + base) << 16); o1.z = (v[12] + base) | ((v[13] + base) << 16); o1.w = (v[14] + base) | ((v[15] + base) << 16);
          *(LAS u32x4*)cp = o0; *(LAS u32x4*)(cp + 8) = o1; }
        __syncthreads();
        { unsigned tau2 = tau; asm volatile("" : "+v"(tau2));
          bf16_t* so = p->sel + (mq0 + gq) * TOPK; const unsigned below = (1u << n) - 1u; const unsigned cG = (unsigned)TOPK - needE;
#pragma unroll
          for (int jb = 0; jb < 16; ++jb) { if (8 * jb < nj) {
#pragma unroll
              for (int jj = 0; jj < 8; ++jj) { const int j = 8 * jb + jj; const unsigned v = mk[j];
                  const bool isg = v > tau2, ise = v == tau2;
                  const unsigned long long bg = __ballot(isg), be = __ballot(ise);
                  if (bg | be) { const int tile = 8 * j + wid;
                      const unsigned mg = (unsigned)(bg >> (16 * gq)) & 0xffffu, me = (unsigned)(be >> (16 * gq)) & 0xffffu;
                      if (isg) { const unsigned slot = cntG[gq * 1024 + tile] + __popc(mg & below); so[slot] = (bf16_t)(16 * tile + n); }
                      else if (ise) { const unsigned rank = cntE[gq * 1024 + tile] + __popc(me & below); if (rank < needE) so[cG + rank] = (bf16_t)(16 * tile + n); } } }
              asm volatile("" ::: "memory"); } } }
        __syncthreads();
    }
}

enum { PH_PRO = 0, PH_XKV, PH_INPROJ, PH_SELECT, PH_MIX, PH_FINISH, PH_GATES, PH_OUT, PH_NORM1, PH_XQ, PH_XS, PH_XSM, PH_XPV, PH_XO, PH_NORM2, PH_GU, PH_DOWN, PH_NORM3, PH_COUNT };

template <int ONLY>
__device__ __forceinline__ void layer_body(KP p, const int l, LAS unsigned char* lds, const XcdBarrier& bar) {
#define RUN(ph) (ONLY < 0 || ONLY == (ph))
#define SYNC() do { if (ONLY < 0) xcd_barrier(bar); } while (0)
    StaticOrder so;

        const bf16_t* wl = p->wt + (size_t)l * WT_LAYER;
        const float* xin = (l == 0) ? p->x : p->out;
        bf16_t* RQ = p->raw; bf16_t* RK = p->raw + (size_t)MTOK * 1024; bf16_t* RV = p->raw + (size_t)MTOK * 2048;
        if (RUN(PH_INPROJ)) { Gemm g = pg8::make_gemm(p->xn, wl + WT_IN, MTOK, 5120, 1024); so.init(MTOK, 5120, gridDim.x, blockIdx.x); pg8::gemm_phase(lds, g, so, EpiInProj{p, l}); }
        SYNC();
        if (RUN(PH_SELECT)) { phase_gdn_prep(p, l, lds); __syncthreads(); phase_dsa_select(p, lds); }
        SYNC();
        if (RUN(PH_MIX)) {
            const int tid_ = tid_opaque(); const int wid_ = __builtin_amdgcn_readfirstlane(tid_ >> 6), lane_ = tid_ & 63;
            volatile LAS unsigned* sflag = (volatile LAS unsigned*)(lds + LDS_BYTES - 48);
            volatile LAS unsigned* f_dma = (volatile LAS unsigned*)(lds + LDS_BYTES - 64); volatile LAS unsigned* f_vr = f_dma + 1; volatile LAS unsigned* f_done = f_dma + 2;
            const unsigned fbase = 256u * (unsigned)l;
            const unsigned qx_ = blockIdx.x & 31u; unsigned* ctr = p->bar + XCD_BAR_WORDS + 64 + 24576 + (l * 32 + (int)qx_) * 16;
            if (blockIdx.x < 128) {
                if (wid_ == 0) { __builtin_amdgcn_s_setprio(1); gdn_scan_unit(p, blockIdx.x, lds, lane_, f_vr, f_done, fbase); __builtin_amdgcn_s_setprio(0);
                    asm volatile("s_waitcnt vmcnt(0) lgkmcnt(0)" ::: "memory"); *sflag = (unsigned)(l + 1); }
                else if (wid_ <= 5) phase_sparse_attn<false>(p, ctr, qx_, lds + SC_END + (wid_ - 1) * 8192, lane_);
                else { if (wid_ == 6) gdn_scan_issuer(p, l, blockIdx.x, lds, lane_, f_dma, f_done, fbase); else gdn_scan_conv(p, l, blockIdx.x, lds, lane_, f_dma, f_vr, f_done, fbase);
                    { unsigned sp_ = 0; while (*sflag < (unsigned)(l + 1) && ++sp_ < SC_SPIN_CAP) __builtin_amdgcn_s_sleep(32); }
                    phase_sparse_attn<true>(p, ctr, qx_, lds + (wid_ - 5) * SA_LDS_WAVE, lane_); }
            } else phase_sparse_attn<true>(p, ctr, qx_, lds + wid_ * SA_LDS_WAVE, lane_);
        }
        SYNC();
        if (RUN(PH_GATES)) { Gemm g = pg8::make_gemm(p->xn, wl + WT_GATE, MTOK, 2048, 1024); so.init(MTOK, 2048, gridDim.x, blockIdx.x); pg8::gemm_phase(lds, g, so, EpiGates{RQ, p->qb, RV, p->gdn_norm + l * 128, lds + 131072}); }
        if (l == 0 && RUN(PH_XKV)) {
            Gemm g = pg8::make_gemm(p->memn, p->wt + WT_XKV, 1024, 2048, 1024); g.bat_div = 2; g.b_bat = WT_LAYER;
            so.init(1024, 2048, gridDim.x, blockIdx.x); pg8::gemm_phase(lds, g, so, EpiXKV{p->xk, p->xvt});
        }
        SYNC();
        if (RUN(PH_OUT)) { Gemm g = pg8::make_gemm(RQ, wl + WT_OUT, MTOK, 1024, 1024); so.init(MTOK, 1024, gridDim.x, blockIdx.x);
            pg8::gemm_phase(lds, g, so, EpiNormFused{xin, p->out, p->xn, p->norm_mix_post + l * 1024, p->norm_x_pre + l * 1024, p->npart, p->bar + XCD_BAR_WORDS + 64 + ((l * 3 + 0) * 2) * 128 * 16, lds + 131072}); }
        SYNC();
        if (RUN(PH_XQ)) { Gemm g = pg8::make_gemm(p->xn, wl + WT_XQ, MTOK, 1024, 1024); so.init(MTOK, 1024, gridDim.x, blockIdx.x); pg8::gemm_phase(lds, g, so, EpiPlain{p->qb, 1024, 0.0625f}); }
        if (ONLY < 0) __syncthreads();
        if (RUN(PH_XS)) {
            Gemm g = pg8::make_gemm(p->qb, p->xk + (size_t)l * 512 * 1024, MTOK, 1024, 256); g.lda = 1024; g.ldb = 1024; g.a_pn = 256; g.b_pn = 256; g.bat_div = 64; g.b_bat = 256l * 1024;
            so.init(MTOK, 1024, gridDim.x, blockIdx.x); pg8::gemm_phase(lds, g, so, EpiSoftmaxP{RV, lds + 131072});
        }
        if (ONLY < 0) __syncthreads();
        if (RUN(PH_XPV)) {
            Gemm g = pg8::make_gemm(RV, p->xvt + (size_t)l * 2 * 4 * 65536, MTOK, 1024, 256); g.lda = 1024; g.ldb = 256; g.a_pn = 256; g.b_pn = 65536; g.bat_div = 64; g.b_bat = 4l * 65536;
            so.init(MTOK, 1024, gridDim.x, blockIdx.x); pg8::gemm_phase(lds, g, so, EpiPlain{p->xn, 1024, 1.0f});
        }
        SYNC();
        if (RUN(PH_XO)) { Gemm g = pg8::make_gemm(p->xn, wl + WT_XO, MTOK, 1024, 1024); so.init(MTOK, 1024, gridDim.x, blockIdx.x);
            pg8::gemm_phase(lds, g, so, EpiNormFused{p->out, p->out, p->xn, p->norm_x_post + l * 1024, p->norm_ffn_pre + l * 1024, p->npart, p->bar + XCD_BAR_WORDS + 64 + ((l * 3 + 1) * 2) * 128 * 16, lds + 131072}); }
        SYNC();
        if (RUN(PH_GU)) { Gemm g = pg8::make_gemm(p->xn, wl + WT_GU, MTOK, 5632, 1024); so.init(MTOK, 5632, gridDim.x, blockIdx.x); pg8::gemm_phase(lds, g, so, EpiSwiGLU{p->raw}); }
        SYNC();
        if (RUN(PH_DOWN)) { Gemm g = pg8::make_gemm(p->raw, wl + WT_DOWN, MTOK, 1024, 2816); so.init(MTOK, 1024, gridDim.x, blockIdx.x);
            pg8::gemm_phase(lds, g, so, EpiNormFused{p->out, p->out, p->xn, p->norm_ffn_post + l * 1024, (l + 1 < DEPTH) ? p->norm_mix_pre + (l + 1) * 1024 : nullptr, p->npart, p->bar + XCD_BAR_WORDS + 64 + ((l * 3 + 2) * 2) * 128 * 16, lds + 131072}); }
        SYNC();

#undef RUN
#undef SYNC
}

template <int ONLY>
__global__ void __launch_bounds__(NTHREADS, 2) fwd_kernel(Params p_unused, int layer_only) {
    KP p = (KP)__builtin_amdgcn_kernarg_segment_ptr();
    extern __shared__ __attribute__((aligned(16))) unsigned char shm[];
    LAS unsigned char* lds = (LAS unsigned char*)shm;
    volatile LAS unsigned* xbw = (volatile LAS unsigned*)(lds + LDS_BYTES - 16);
    XcdBarrier bar;
    if (ONLY < 0) {
        if (threadIdx.x == 0) { xbw[0] = 0u; xbw[1] = 0u; xbw[2] = 0u; xbw[3] = 0u; xbw[-8] = 0u; xbw[-12] = 0u; xbw[-11] = 0u; xbw[-10] = 0u; }
        __syncthreads();
        bar = xcd_barrier_post(p->bar, xbw);
    }
#define RUN(ph) (ONLY < 0 || ONLY == (ph))
#define SYNC() do { if (ONLY < 0) xcd_barrier(bar); } while (0)
    StaticOrder so;
    if (RUN(PH_PRO)) { phase_prologue(p, lds); }
    SYNC();
    if (ONLY < 0) { layer_body<ONLY>(p, 0, lds, bar); layer_body<ONLY>(p, 1, lds, bar); } else { layer_body<ONLY>(p, layer_only, lds, bar); }
#undef RUN
#undef SYNC
}

static inline size_t align_up(size_t v, size_t a) { return (v + a - 1) / a * a; }

extern "C" void kernel_launch(void* const* d_in, const int* in_sizes, int n_in, void* d_out, int out_size, void* d_ws, size_t ws_size, hipStream_t stream) {
    (void)in_sizes; (void)n_in; (void)out_size;
    Params p;
    memset(&p, 0, sizeof(p));
    p.x = (const float*)d_in[0]; p.mem = (const float*)d_in[1]; p.positions = (const int*)d_in[2];
    p.norm_mix_pre = (const float*)d_in[3]; p.w_in = (const float*)d_in[4]; p.conv_w = (const float*)d_in[5]; p.a_log = (const float*)d_in[6]; p.dt_bias = (const float*)d_in[7];
    p.gdn_norm = (const float*)d_in[8]; p.w_out = (const float*)d_in[9]; p.norm_mix_post = (const float*)d_in[10]; p.norm_x_pre = (const float*)d_in[11]; p.norm_mem = (const float*)d_in[12];
    p.w_xq = (const float*)d_in[13]; p.w_xkv = (const float*)d_in[14]; p.w_xo = (const float*)d_in[15]; p.norm_x_post = (const float*)d_in[16]; p.norm_ffn_pre = (const float*)d_in[17];
    p.w_gu = (const float*)d_in[18]; p.w_down = (const float*)d_in[19]; p.norm_ffn_post = (const float*)d_in[20];
    p.out = (float*)d_out;
    char* w = (char*)d_ws; size_t off = 0;
    auto take = [&](size_t bytes) { char* r = w + off; off = align_up(off + bytes, 256); return r; };
    p.bar = (unsigned*)take((XCD_BAR_WORDS + 64 + 24576 + 1024) * 4);
    constexpr size_t TA_BYTES = (size_t)4096 * 8192 * 2, TA_DEAD = (size_t)2 * 512 * 1024 * 2 + (size_t)2 * MTOK * 64 * 4 + (size_t)WT_LAYER * 2;
    static_assert(TA_DEAD < TA_BYTES && (TA_BYTES - TA_DEAD) % 256 == 0 && ((size_t)WT_LAYER * 2) % 256 == 0, "overlay arithmetic");
    p.ta = (bf16_t*)take(TA_BYTES - TA_DEAD);
    p.memn = (bf16_t*)take((size_t)2 * 512 * 1024 * 2);
    p.rope_cos = (float*)take((size_t)MTOK * 64 * 4); p.rope_sin = (float*)take((size_t)MTOK * 64 * 4);
    p.wt = (bf16_t*)take((size_t)2 * WT_LAYER * 2);
    p.xk = (bf16_t*)take((size_t)2 * 512 * 1024 * 2); p.xvt = (bf16_t*)take((size_t)2 * 2 * 4 * 65536 * 2);
    p.xn = (bf16_t*)take((size_t)MTOK * 1024 * 2); p.qb = (bf16_t*)take((size_t)MTOK * 1024 * 2);
    p.kb = (bf16_t*)take((size_t)MTOK * 256 * 2); p.vb = (bf16_t*)take((size_t)MTOK * 256 * 2); p.qib = (bf16_t*)take((size_t)MTOK * 256 * 2); p.kib = (bf16_t*)take((size_t)MTOK * 64 * 2);
    p.wi = (float*)take((size_t)MTOK * 4 * 4); p.gg = (float*)take((size_t)MTOK * 8 * 4); p.beta = (float*)take((size_t)MTOK * 8 * 4);
    p.raw = (bf16_t*)take((size_t)MTOK * 3072 * 2); p.sel = (bf16_t*)take((size_t)MTOK * TOPK * 2);
    p.halo = (bf16_t*)take((size_t)(MTOK / 64) * 3 * 2048 * 2);
    p.npart = (float*)take((size_t)2 * MTOK * 4 * 4);
    if ((size_t)((char*)(p.wt + WT_LAYER) - (char*)p.ta) < TA_BYTES) { fprintf(stderr, "kernel_launch: overlay span too short\n"); return; }
    if (off > ws_size) { fprintf(stderr, "kernel_launch: workspace too small: need %zu have %zu\n", off, ws_size); return; }

    static int grid = 0;
    if (!grid) {
        int dev = 0, cus = 0, per_cu = 0;
        (void)hipGetDevice(&dev); (void)hipDeviceGetAttribute(&cus, hipDeviceAttributeMultiprocessorCount, dev);
        if (hipFuncSetAttribute((const void*)fwd_kernel<-1>, hipFuncAttributeMaxDynamicSharedMemorySize, LDS_BYTES) != hipSuccess) { fprintf(stderr, "kernel_launch: hipFuncSetAttribute failed\n"); grid = -1; return; }
        if (hipOccupancyMaxActiveBlocksPerMultiprocessor(&per_cu, (const void*)fwd_kernel<-1>, NTHREADS, LDS_BYTES) != hipSuccess || per_cu < 1) fprintf(stderr, "kernel_launch: occupancy query reports %d\n", per_cu);
        grid = cus > 0 ? cus : 256;
        if (grid > 256) grid = 256;
    }
    if (grid <= 0) return;
    (void)hipMemsetAsync(p.bar, 0, (XCD_BAR_WORDS + 64 + 24576 + 1024) * sizeof(unsigned), stream);
    hipLaunchKernelGGL(fwd_kernel<-1>, dim3(grid), dim3(NTHREADS), LDS_BYTES, stream, p, 0);
}
```

```cpp
#include <hip/hip_runtime.h>
#include <stdint.h>
#include <stdio.h>
#include <math.h>
#include <string.h>

#define LAS __attribute__((address_space(3)))
typedef unsigned short bf16_t;
typedef short bf16x8 __attribute__((ext_vector_type(8)));
typedef float f32x4 __attribute__((ext_vector_type(4)));
typedef float f32x2 __attribute__((ext_vector_type(2)));
typedef unsigned u32x4 __attribute__((ext_vector_type(4)));
typedef unsigned u32x2 __attribute__((ext_vector_type(2)));

constexpr int D_MODEL = 1024, BATCH = 2, SEQ = 16384, DEPTH = 2, MTOK = BATCH * SEQ;
constexpr int N_MEM = 256, FF = 2816, IN_COLS = 6996, TOPK = 256;
constexpr int OFF_AQ = 0, OFF_AK = 1024, OFF_AV = 1280, OFF_IQ = 1536, OFF_IK = 1792, OFF_IW = 1856, OFF_BQKV = 1860, OFF_BA = 4932, OFF_BB = 4940, OFF_GA = 4948, OFF_GB = 5972;
constexpr float EPS = 1e-6f;
constexpr int NTHREADS = 512, NWAVES = 8;
constexpr int LDS_BYTES = 151552;
constexpr int LDS_SCRATCH = 131072;

typedef __bf16 bf16x2_t __attribute__((ext_vector_type(2)));
__device__ __forceinline__ unsigned cvt_pk_bf16(float lo, float hi) { const f32x2 v = {lo, hi}; const bf16x2_t r = __builtin_convertvector(v, bf16x2_t); return __builtin_bit_cast(unsigned, r); }
__device__ __forceinline__ bf16_t f2bf(float x) { return (bf16_t)(cvt_pk_bf16(x, 0.f) & 0xffffu); }
__device__ __forceinline__ float bf2f(bf16_t x) { return __uint_as_float(((unsigned)x) << 16); }
__device__ __forceinline__ float bflo(unsigned w) { return __uint_as_float(w << 16); }
__device__ __forceinline__ float bfhi(unsigned w) { return __uint_as_float(w & 0xffff0000u); }
__device__ __forceinline__ float relu_(float x) { return __int_as_float(max(__float_as_int(x), 0)); }
__device__ __forceinline__ float sigmoidf_(float x) { return __builtin_amdgcn_rcpf(1.0f + __expf(-x)); }
__device__ __forceinline__ int tid_opaque() { int t = threadIdx.x; asm volatile("" : "+v"(t)); return t; }
#define WS_DPP(v, ctrl, rowmask) __int_as_float(__builtin_amdgcn_update_dpp(0, __float_as_int(v), (ctrl), (rowmask), 0xf, false))
__device__ __forceinline__ float wave_sum(float v) {
    v += WS_DPP(v, 0x111, 0xf); v += WS_DPP(v, 0x112, 0xf); v += WS_DPP(v, 0x114, 0xf); v += WS_DPP(v, 0x118, 0xf);
    v += WS_DPP(v, 0x142, 0xa); v += WS_DPP(v, 0x143, 0xc);
    return __int_as_float(__builtin_amdgcn_readlane(__float_as_int(v), 63));
}
__device__ __forceinline__ float wave_max(float v) {
#pragma unroll
    for (int o = 32; o > 0; o >>= 1) v = fmaxf(v, __shfl_xor(v, o));
    return v;
}

#define XB_TMO      128
#define XB_XCNT(j)  (256  + 64 * (j))
#define XB_XSUB(j)  (1280 + 64 * (j))
#define XB_XGEN(j)  (2304 + 64 * (j))
#define XB_TOP      3328
#define XB_TOPGEN   3392
#define XCD_BAR_WORDS 3456
#define XB_SPIN_CAP (1u << 25)

__device__ __forceinline__ unsigned xb_ld(unsigned* p)              { return __hip_atomic_load(p, __ATOMIC_RELAXED, __HIP_MEMORY_SCOPE_AGENT); }
__device__ __forceinline__ unsigned xb_add(unsigned* p, unsigned v) { return __hip_atomic_fetch_add(p, v, __ATOMIC_RELAXED, __HIP_MEMORY_SCOPE_AGENT); }
__device__ __forceinline__ unsigned xb_xcc_id() { return (unsigned)__builtin_amdgcn_s_getreg((3 << 11) | 20) & 0xFu; }
#define XB_SPIN(cond, bar) do { unsigned _sp = 0; while (cond) { __builtin_amdgcn_s_sleep(1); \
    if ((++_sp & 255u) == 0u) { if (xb_ld(&(bar)[XB_TMO])) break; if (_sp > XB_SPIN_CAP) { atomicAdd(&(bar)[XB_TMO], 1u); break; } } } } while (0)

struct XcdBarrier { unsigned* bar; unsigned x; volatile LAS unsigned* st; };

__device__ __forceinline__ XcdBarrier xcd_barrier_post(unsigned* bar, volatile LAS unsigned* st) {
    XcdBarrier b; b.bar = bar; b.x = xb_xcc_id(); b.st = st;
    if (threadIdx.x == 0) (void)xb_add(&bar[XB_XCNT(b.x)], 1u);
    return b;
}
__device__ __forceinline__ void xcd_barrier_complete(unsigned* bar, unsigned x, unsigned& nloc, unsigned& nx) {
    const unsigned G = gridDim.x * gridDim.y * gridDim.z;
    unsigned sum, cnt, mine, sp = 0u;
    for (;;) {
        sum = 0u; cnt = 0u; mine = 0u;
#pragma unroll
        for (unsigned j = 0; j < 16; ++j) { const unsigned c = xb_ld(&bar[XB_XCNT(j)]); sum += c; cnt += (c > 0u) ? 1u : 0u; mine = (j == x) ? c : mine; }
        if (sum == G) break;
        __builtin_amdgcn_s_sleep(1);
        if ((++sp & 255u) == 0u) { if (xb_ld(&bar[XB_TMO])) break; if (sp > XB_SPIN_CAP) { atomicAdd(&bar[XB_TMO], 1u); break; } }
    }
    nloc = mine > 0u ? mine : 1u; nx = cnt > 0u ? cnt : 1u;
}
__device__ __forceinline__ void xcd_barrier(const XcdBarrier& b) {
    asm volatile("s_waitcnt vmcnt(0)" ::: "memory");
    __syncthreads();
    if (threadIdx.x == 0) {
        unsigned* bar = b.bar;
        __builtin_amdgcn_s_waitcnt(0);
        unsigned nloc = b.st[0], nx = b.st[1];
        if (nloc == 0u) { xcd_barrier_complete(bar, b.x, nloc, nx); b.st[0] = nloc; b.st[1] = nx; }
        const unsigned old = xb_add(&bar[XB_XSUB(b.x)], 1u);
        const unsigned gen = old / nloc;
        if (old + 1u == (gen + 1u) * nloc) {
            __builtin_amdgcn_fence(__ATOMIC_RELEASE, "agent");
            asm volatile("s_waitcnt vmcnt(0)" ::: "memory");
            const unsigned og = xb_add(&bar[XB_TOP], 1u);
            const unsigned tg = og / nx;
            if (og + 1u == (tg + 1u) * nx) xb_add(&bar[XB_TOPGEN], 1u);
            else XB_SPIN(xb_ld(&bar[XB_TOPGEN]) == tg, bar);
            __builtin_amdgcn_fence(__ATOMIC_ACQUIRE, "agent");
            xb_add(&bar[XB_XGEN(b.x)], 1u);
            asm volatile("s_waitcnt vmcnt(0)" ::: "memory");
        } else {
            XB_SPIN(xb_ld(&bar[XB_XGEN(b.x)]) == gen, bar);
            __builtin_amdgcn_fence(__ATOMIC_ACQUIRE, "agent");
            asm volatile("s_waitcnt vmcnt(0)" ::: "memory");
        }
    }
    __syncthreads();
}

namespace pg8 {
constexpr int BM = 256, BK = 64, HALF = 128, HTB = HALF * BK * 2, STAGE_BYTES = 8 * HTB, NXCD = 8, WGM = 8;
__host__ __device__ __forceinline__ int lds_byte(int r, int c) { const int st = (r >> 4) * 2 + (c >> 5), rr = r & 15, cc = c & 31, ob = rr * 64 + cc * 2; return st * 1024 + (ob ^ (((ob >> 9) & 1) << 5)); }
__host__ __device__ __forceinline__ void stage_rc(int b, int& R, int& C) { const int st = b / 1024, sb = b % 1024, swz = sb ^ (((sb >> 9) & 1) << 5); R = (st >> 1) * 16 + swz / 64; C = (st & 1) * 32 + (swz % 64) / 2; }
struct Unit { int pm, pn; };
struct Gemm {
    const bf16_t* A; const bf16_t* Bt; int lda, ldb, K, M, N; long a_pn, b_pn; int bat_div; long b_bat;
    __device__ __forceinline__ const char* abase(const Unit& u) const { return (const char*)(A + (long)u.pm * BM * lda + (long)u.pn * a_pn); }
    __device__ __forceinline__ const char* bbase(const Unit& u) const { return (const char*)(Bt + (long)u.pn * b_pn + (bat_div ? (long)(u.pm / bat_div) * b_bat : 0l)); }
};
__host__ __device__ inline Gemm make_gemm(const bf16_t* A, const bf16_t* Bt, int M, int N, int K) { Gemm g; g.A = A; g.Bt = Bt; g.lda = K; g.ldb = K; g.K = K; g.M = M; g.N = N; g.a_pn = 0; g.b_pn = (long)BM * K; g.bat_div = 0; g.b_bat = 0; return g; }

struct StaticOrder {
    int nM, nN, nwg, G, c;
    __host__ __device__ void init(int M, int N, int G_, int c_) { nM = M / BM; nN = N / BM; nwg = nM * nN; G = G_; c = c_; }
    __host__ __device__ bool next(int i, Unit& u) const {
        const long L = (long)i * G + c; if (L >= nwg) return false;
        int wgid = (int)L; { const int q = nwg / NXCD, r = nwg % NXCD, xcd = wgid % NXCD, off = wgid / NXCD; wgid = (xcd < r ? xcd * (q + 1) : r * (q + 1) + (xcd - r) * q) + off; }
        const int nig = WGM * nN, gid = wgid / nig, fm = gid * WGM, gsz = (nM - fm) < WGM ? (nM - fm) : WGM;
        u.pm = fm + ((wgid % nig) % gsz); u.pn = (wgid % nig) / gsz; return true;
    }
};

template <class Epi>
__device__ __forceinline__ void gemm_phase(LAS unsigned char* lds, const Gemm g, const StaticOrder& S, const Epi& E) {
    const int tid = tid_opaque(), wid = __builtin_amdgcn_readfirstlane(tid >> 6), lane = tid & 63, wr = wid >> 2, wc = wid & 3, fr = lane & 15, fq = lane >> 4;
    const int K = g.K, nt = K / BK;
    unsigned voffA[2], voffB[2];
#pragma unroll
    for (int i = 0; i < 2; ++i) { int R, C; stage_rc(tid * 16 + i * 8192, R, C); voffA[i] = (unsigned)(R * g.lda + C) * 2u; voffB[i] = (unsigned)(R * g.ldb + C) * 2u; }
    const size_t kstep = (size_t)(BK * 2);
    const size_t hstepA = (size_t)HALF * g.lda * 2, hstepB = (size_t)HALF * g.ldb * 2;
    const unsigned ldsw = (unsigned)wid * 1024u;
    const int aoff = lds_byte(wr * 64 + fr, fq * 8), boff = lds_byte(wc * 32 + fr, fq * 8);
#define PG8_SA(b, h) (((b) * 2 + (h)) * HTB)
#define PG8_SB(b, h) ((4 + (b) * 2 + (h)) * HTB)
#define PG8_STAGE(bufoff, gbase, voff) do { _Pragma("unroll") for (int _i = 0; _i < 2; ++_i) \
        __builtin_amdgcn_global_load_lds((const unsigned*)((const char*)(gbase) + (voff)[_i]), (LAS unsigned*)(lds + (bufoff) + ldsw + _i * 8192), 16, 0, 0); } while (0)
#define PG8_LDA(dst, b, h) do { _Pragma("unroll") for (int m = 0; m < 4; ++m) _Pragma("unroll") for (int k = 0; k < 2; ++k) dst[m][k] = *(const LAS bf16x8*)(lds + PG8_SA(b, h) + aoff + m * 2048 + k * 1024); } while (0)
#define PG8_LDB(dst, b, h) do { _Pragma("unroll") for (int n = 0; n < 2; ++n) _Pragma("unroll") for (int k = 0; k < 2; ++k) dst[n][k] = *(const LAS bf16x8*)(lds + PG8_SB(b, h) + boff + n * 2048 + k * 1024); } while (0)
#define PG8_MMA(ai, bj, At, Bt) do { __builtin_amdgcn_s_setprio(1); _Pragma("unroll") for (int m = 0; m < 4; ++m) _Pragma("unroll") for (int n = 0; n < 2; ++n) _Pragma("unroll") for (int k = 0; k < 2; ++k) \
        acc[ai][bj][m][n] = __builtin_amdgcn_mfma_f32_16x16x32_bf16(Bt[n][k], At[m][k], acc[ai][bj][m][n], 0, 0, 0); __builtin_amdgcn_s_setprio(0); } while (0)
#define PG8_WAIT_V(n) asm volatile("s_waitcnt vmcnt(" #n ")" ::: "memory")
#define PG8_WAIT_L(n) asm volatile("s_waitcnt lgkmcnt(" #n ")" ::: "memory")
#define PG8_BAR __builtin_amdgcn_s_barrier()
#define PG8_SCHED __builtin_amdgcn_sched_barrier(0)
    Unit cur, nxt; int ui = 0;
    if (!S.next(0, cur)) return;
    f32x4 acc[2][2][4][2];
#pragma unroll
    for (int a = 0; a < 2; ++a)
#pragma unroll
        for (int b = 0; b < 2; ++b)
#pragma unroll
            for (int m = 0; m < 4; ++m)
#pragma unroll
                for (int n = 0; n < 2; ++n) acc[a][b][m][n] = (f32x4){0.f, 0.f, 0.f, 0.f};
    bf16x8 At[4][2], B0[2][2], B1[2][2];
    const char* cA = g.abase(cur); const char* cB = g.bbase(cur);
    PG8_STAGE(PG8_SB(0, 0), cB, voffB); PG8_STAGE(PG8_SB(0, 1), cB + hstepB, voffB); PG8_STAGE(PG8_SA(0, 0), cA, voffA); PG8_STAGE(PG8_SA(0, 1), cA + hstepA, voffA);
    if (wr == 1) PG8_BAR;
    PG8_WAIT_V(2); PG8_BAR;
    PG8_STAGE(PG8_SB(1, 0), cB + kstep, voffB); PG8_STAGE(PG8_SA(1, 0), cA + kstep, voffA); PG8_STAGE(PG8_SB(1, 1), cB + hstepB + kstep, voffB);
    PG8_WAIT_V(6); PG8_BAR;
    for (;;) {
        const bool has_next = S.next(ui + 1, nxt);
        const char* nA = has_next ? g.abase(nxt) : cA; const char* nB = has_next ? g.bbase(nxt) : cB;
        for (int t = 0; t < nt; t += 2) {
            const bool last = (t == nt - 2);
            const char* a1 = cA + (size_t)(t + 1) * kstep;
            const char* a2 = last ? nA : cA + (size_t)(t + 2) * kstep; const char* b2 = last ? nB : cB + (size_t)(t + 2) * kstep;
            const char* a3 = a2 + kstep; const char* b3 = b2 + kstep;
            PG8_LDB(B0, 0, 0); PG8_LDB(B1, 0, 1); PG8_SCHED; PG8_LDA(At, 0, 0); PG8_STAGE(PG8_SA(1, 1), a1 + hstepA, voffA);
            PG8_WAIT_V(8); PG8_WAIT_L(0); PG8_BAR; PG8_MMA(0, 0, At, B0); PG8_MMA(0, 1, At, B1); PG8_BAR; PG8_SCHED;
            PG8_LDA(At, 0, 1); PG8_STAGE(PG8_SB(0, 0), b2, voffB); PG8_STAGE(PG8_SB(0, 1), b2 + hstepB, voffB); PG8_STAGE(PG8_SA(0, 0), a2, voffA);
            PG8_WAIT_V(8); PG8_WAIT_L(0); PG8_BAR; PG8_MMA(1, 0, At, B0); PG8_MMA(1, 1, At, B1); PG8_BAR; PG8_SCHED;
            PG8_LDB(B0, 1, 0); PG8_LDB(B1, 1, 1); PG8_SCHED; PG8_LDA(At, 1, 0); PG8_STAGE(PG8_SA(0, 1), a2 + hstepA, voffA);
            PG8_WAIT_V(8); PG8_WAIT_L(0); PG8_BAR; PG8_MMA(0, 0, At, B0); PG8_MMA(0, 1, At, B1); PG8_BAR; PG8_SCHED;
            PG8_LDA(At, 1, 1); PG8_STAGE(PG8_SB(1, 0), b3, voffB); PG8_STAGE(PG8_SB(1, 1), b3 + hstepB, voffB); PG8_STAGE(PG8_SA(1, 0), a3, voffA);
            PG8_WAIT_V(8); PG8_WAIT_L(0); PG8_BAR; PG8_MMA(1, 0, At, B0); PG8_MMA(1, 1, At, B1); PG8_BAR; PG8_SCHED;
        }
        if (wr == 0) PG8_BAR;
        E(acc, cur, wr, wc, fr, fq);
        if (!has_next) break;
#pragma unroll
        for (int a = 0; a < 2; ++a)
#pragma unroll
            for (int b = 0; b < 2; ++b)
#pragma unroll
                for (int m = 0; m < 4; ++m)
#pragma unroll
                    for (int n = 0; n < 2; ++n) acc[a][b][m][n] = (f32x4){0.f, 0.f, 0.f, 0.f};
        cur = nxt; cA = nA; cB = nB; ++ui;
        if (wr == 1) PG8_BAR;
    }
    PG8_WAIT_V(0);
    PG8_BAR;
#undef PG8_SA
#undef PG8_SB
#undef PG8_STAGE
#undef PG8_LDA
#undef PG8_LDB
#undef PG8_MMA
#undef PG8_WAIT_V
#undef PG8_WAIT_L
#undef PG8_BAR
#undef PG8_SCHED
}
}
using pg8::Unit; using pg8::Gemm; using pg8::StaticOrder;

struct Params {
    const float* x; const float* mem; const int* positions;
    const float* norm_mix_pre; const float* w_in; const float* conv_w; const float* a_log; const float* dt_bias; const float* gdn_norm; const float* w_out;
    const float* norm_mix_post; const float* norm_x_pre; const float* norm_mem; const float* w_xq; const float* w_xkv; const float* w_xo; const float* norm_x_post;
    const float* norm_ffn_pre; const float* w_gu; const float* w_down; const float* norm_ffn_post;
    float* out;
    unsigned* bar;
    bf16_t* wt;
    float* rope_cos; float* rope_sin;
    bf16_t* memn;
    bf16_t* xk;
    bf16_t* xvt;
    bf16_t* xn;
    bf16_t* qb;
    bf16_t* kb; bf16_t* vb; bf16_t* qib; bf16_t* kib;
    float* wi; float* gg; float* beta;
    bf16_t* raw;
    bf16_t* sel;
    bf16_t* halo;
    bf16_t* ta;
    float* npart;
};
typedef const __attribute__((address_space(4))) Params* KP;
constexpr long WT_IN = 0, WT_GATE = WT_IN + 5120l * 1024, WT_OUT = WT_GATE + 2048l * 1024, WT_XQ = WT_OUT + 1024l * 1024, WT_XKV = WT_XQ + 1024l * 1024,
               WT_XO = WT_XKV + 2048l * 1024, WT_GU = WT_XO + 1024l * 1024, WT_DOWN = WT_GU + 5632l * 1024, WT_LAYER = WT_DOWN + 1024l * 2816;

__device__ __forceinline__ int map_plain(int c) { return (c & ~31) + 8 * ((c >> 2) & 3) + 4 * ((c >> 4) & 1) + (c & 3); }
__device__ __forceinline__ int map_pair(int c, int second_off) {
    const int blk = c >> 7, wc = (c >> 5) & 3, n = (c >> 4) & 1, fq = (c >> 2) & 3, i = c & 3; const int cc = 64 * blk + 16 * wc + 4 * fq + i; return n ? second_off + cc : cc; }
__device__ __forceinline__ int map_in(int c) {
    const int pn = c >> 8, bj = (c >> 7) & 1, wc = (c >> 5) & 3, n = (c >> 4) & 1, fq = (c >> 2) & 3, i = c & 3;
    if (pn < 5) { const int head = (pn < 4) ? 2 * pn + bj : bj; const int d = n * 64 + 16 * wc + 4 * fq + i; return (pn < 4 ? OFF_AQ : OFF_AK) + head * 128 + d; }
    if (pn == 5) return OFF_AV + map_plain(c & 255);
    if (pn == 6) { const int head = 2 * bj + (wc >> 1); const int d = n * 32 + 16 * (wc & 1) + 4 * fq + i; return OFF_IQ + head * 64 + d; }
    if (pn == 7) {
        if (bj == 1 || wc == 3) return -1;
        if (wc < 2) return OFF_IK + n * 32 + 16 * wc + 4 * fq + i;
        const int s = 16 * n + 4 * fq + i;
        if (s < 4) return OFF_IW + s; if (s < 12) return OFF_BA + (s - 4); if (s < 20) return OFF_BB + (s - 12); return -1;
    }
    return OFF_BQKV + map_plain(c - 2048);
}
struct WtTile { const float* src; bf16_t* dst; int ld, K, n0, k0, kind, soff; };
__device__ __forceinline__ int wt_col(const WtTile& w, int c) { return w.kind == 0 ? map_plain(c) : (w.kind == 1 ? map_pair(c, w.soff) : map_in(c)); }
__device__ __forceinline__ void load_row_f32(const float* p, float (&v)[16]) {
#pragma unroll
    for (int j = 0; j < 4; ++j) { const f32x4 t = *(const f32x4*)(p + 4 * j); v[4 * j] = t[0]; v[4 * j + 1] = t[1]; v[4 * j + 2] = t[2]; v[4 * j + 3] = t[3]; }
}
__device__ __forceinline__ void load_row_bf16(const bf16_t* p, float (&v)[16]) {
#pragma unroll
    for (int j = 0; j < 2; ++j) { const u32x4 t = *(const u32x4*)(p + 8 * j);
        v[8 * j] = bflo(t.x); v[8 * j + 1] = bfhi(t.x); v[8 * j + 2] = bflo(t.y); v[8 * j + 3] = bfhi(t.y); v[8 * j + 4] = bflo(t.z); v[8 * j + 5] = bfhi(t.z); v[8 * j + 6] = bflo(t.w); v[8 * j + 7] = bfhi(t.w); }
}
__device__ __forceinline__ void store_row_bf16(bf16_t* p, const float (&v)[16]) {
#pragma unroll
    for (int j = 0; j < 2; ++j) { u32x4 w; w.x = cvt_pk_bf16(v[8 * j], v[8 * j + 1]); w.y = cvt_pk_bf16(v[8 * j + 2], v[8 * j + 3]); w.z = cvt_pk_bf16(v[8 * j + 4], v[8 * j + 5]); w.w = cvt_pk_bf16(v[8 * j + 6], v[8 * j + 7]);
        *(u32x4*)(p + 8 * j) = w; }
}
__device__ __forceinline__ void store_row_f32(float* p, const float (&v)[16]) {
#pragma unroll
    for (int j = 0; j < 4; ++j) *(f32x4*)(p + 4 * j) = (f32x4){v[4 * j], v[4 * j + 1], v[4 * j + 2], v[4 * j + 3]};
}
__device__ __forceinline__ void phase_norm_rows(const float* x, const float* g, bf16_t* xn, int nrows) {
    const int tid = tid_opaque(); const int lane = tid & 63, gw = blockIdx.x * NWAVES + (tid >> 6), nw = gridDim.x * NWAVES;
    float gv[16]; load_row_f32(g + lane * 16, gv);
    for (int r = gw; r < nrows; r += nw) {
        float v[16]; load_row_f32(x + (size_t)r * 1024 + lane * 16, v);
        float s = 0.f;
#pragma unroll
        for (int j = 0; j < 16; ++j) s += v[j] * v[j];
        s = wave_sum(s); const float rs = rsqrtf(s * (1.0f / 1024.f) + EPS);
#pragma unroll
        for (int j = 0; j < 16; ++j) v[j] = v[j] * rs * gv[j];
        store_row_bf16(xn + (size_t)r * 1024 + lane * 16, v);
    }
}
__device__ __forceinline__ void phase_prologue(KP p, LAS unsigned char* lds) {
    constexpr int T_IN = (5120 / 64) * 16, T_GATE = (2048 / 64) * 16, T_SQ = 16 * 16, T_XKV = 32 * 16, T_GU = (5632 / 64) * 16, T_DOWN = 16 * 44;
    constexpr int T_LAYER = T_IN + T_GATE + 3 * T_SQ + T_XKV + T_GU + T_DOWN;
    auto decode = [&](int t) -> WtTile {
        const int l = t / T_LAYER; int r = t % T_LAYER; bf16_t* wl = p->wt + (size_t)l * WT_LAYER; WtTile w;
        if (r < T_IN) { w = WtTile{p->w_in + (size_t)l * 1024 * IN_COLS, wl + WT_IN, IN_COLS, 1024, (r >> 4) * 64, (r & 15) * 64, 2, 0}; return w; } r -= T_IN;
        if (r < T_GATE) { w = WtTile{p->w_in + (size_t)l * 1024 * IN_COLS + OFF_GA, wl + WT_GATE, IN_COLS, 1024, (r >> 4) * 64, (r & 15) * 64, 1, 1024}; return w; } r -= T_GATE;
        if (r < T_SQ) { w = WtTile{p->w_out + (size_t)l * 1024 * 1024, wl + WT_OUT, 1024, 1024, (r >> 4) * 64, (r & 15) * 64, 0, 0}; return w; } r -= T_SQ;
        if (r < T_SQ) { w = WtTile{p->w_xq + (size_t)l * 1024 * 1024, wl + WT_XQ, 1024, 1024, (r >> 4) * 64, (r & 15) * 64, 0, 0}; return w; } r -= T_SQ;
        if (r < T_XKV) { w = WtTile{p->w_xkv + (size_t)l * 1024 * 2048, wl + WT_XKV, 2048, 1024, (r >> 4) * 64, (r & 15) * 64, 0, 0}; return w; } r -= T_XKV;
        if (r < T_SQ) { w = WtTile{p->w_xo + (size_t)l * 1024 * 1024, wl + WT_XO, 1024, 1024, (r >> 4) * 64, (r & 15) * 64, 0, 0}; return w; } r -= T_SQ;
        if (r < T_GU) { w = WtTile{p->w_gu + (size_t)l * 1024 * 5632, wl + WT_GU, 5632, 1024, (r >> 4) * 64, (r & 15) * 64, 1, 2816}; return w; } r -= T_GU;
        w = WtTile{p->w_down + (size_t)l * 2816 * 1024, wl + WT_DOWN, 1024, 2816, (r / 44) * 64, (r % 44) * 64, 0, 0}; return w; };
    { const int tid = tid_opaque(); const int nl = tid & 63, kb = tid >> 6, nl2 = tid >> 3, kk = (tid & 7) * 8;
      for (int t0 = blockIdx.x; t0 < 2 * T_LAYER; t0 += 4 * gridDim.x) {
          float v[4][8];
#pragma unroll
          for (int g = 0; g < 4; ++g) { const int t = t0 + g * gridDim.x;
              if (t < 2 * T_LAYER) { const WtTile w = decode(t); const int col = wt_col(w, w.n0 + nl);
#pragma unroll
                  for (int q = 0; q < 8; ++q) v[g][q] = col >= 0 ? w.src[(size_t)(w.k0 + q * 8 + kb) * w.ld + col] : 0.f; } }
#pragma unroll
          for (int g = 0; g < 4; ++g) { const int t = t0 + g * gridDim.x; LAS float* tile = (LAS float*)lds + g * (64 * 65);
              if (t < 2 * T_LAYER) {
#pragma unroll
                  for (int q = 0; q < 8; ++q) tile[(q * 8 + kb) * 65 + nl] = v[g][q]; } }
          __syncthreads();
#pragma unroll
          for (int g = 0; g < 4; ++g) { const int t = t0 + g * gridDim.x; const LAS float* tile = (const LAS float*)lds + g * (64 * 65);
              if (t < 2 * T_LAYER) { const WtTile w = decode(t); float x[8];
#pragma unroll
                  for (int j = 0; j < 8; ++j) x[j] = tile[(kk + j) * 65 + nl2];
                  u32x4 o; o.x = cvt_pk_bf16(x[0], x[1]); o.y = cvt_pk_bf16(x[2], x[3]); o.z = cvt_pk_bf16(x[4], x[5]); o.w = cvt_pk_bf16(x[6], x[7]);
                  *(u32x4*)(w.dst + (size_t)(w.n0 + nl2) * w.K + w.k0 + kk) = o; } }
          __syncthreads();
      } }
    for (size_t i = (size_t)blockIdx.x * NTHREADS + tid_opaque(); i < (size_t)MTOK * 64; i += (size_t)gridDim.x * NTHREADS) {
        const int m = (int)(i >> 6), j = (int)(i & 63);
        const float inv_freq = exp2f(-(float)j * 0.20762050593046015f);
        const double a = (double)p->positions[m] * (double)inv_freq * 0.15915494309189535;
        const float fr = (float)(a - floor(a));
        p->rope_cos[i] = __builtin_amdgcn_cosf(fr); p->rope_sin[i] = __builtin_amdgcn_sinf(fr);
    }
    phase_norm_rows(p->mem, p->norm_mem, p->memn, BATCH * N_MEM);
    phase_norm_rows(p->mem, p->norm_mem + 1024, p->memn + (size_t)BATCH * N_MEM * 1024, BATCH * N_MEM);
    phase_norm_rows(p->x, p->norm_mix_pre, p->xn, MTOK);
}

struct EpiPlain {
    bf16_t* O; int ldc; float scale;
    __device__ __forceinline__ void operator()(const f32x4 (&acc)[2][2][4][2], const Unit& u, int wr, int wc, int fr, int fq) const {
        const int row0 = u.pm * 256 + wr * 64 + fr, col0 = u.pn * 256 + wc * 32 + 8 * fq;
#pragma unroll
        for (int ai = 0; ai < 2; ++ai)
#pragma unroll
            for (int m = 0; m < 4; ++m) { bf16_t* rowp = O + (size_t)(row0 + ai * 128 + m * 16) * ldc + col0;
#pragma unroll
                for (int bj = 0; bj < 2; ++bj) { const f32x4 v0 = acc[ai][bj][m][0] * scale, v1 = acc[ai][bj][m][1] * scale;
                    u32x4 w; w.x = cvt_pk_bf16(v0[0], v0[1]); w.y = cvt_pk_bf16(v0[2], v0[3]); w.z = cvt_pk_bf16(v1[0], v1[1]); w.w = cvt_pk_bf16(v1[2], v1[3]);
                    *(u32x4*)(rowp + bj * 128) = w; } }
    }
};
struct EpiF32 {
    float* C; int ldc;
    __device__ __forceinline__ void operator()(const f32x4 (&acc)[2][2][4][2], const Unit& u, int wr, int wc, int fr, int fq) const {
        const int row0 = u.pm * 256 + wr * 64 + fr, col0 = u.pn * 256 + wc * 32 + 4 * fq;
#pragma unroll
        for (int ai = 0; ai < 2; ++ai)
#pragma unroll
            for (int m = 0; m < 4; ++m) { float* rowp = C + (size_t)(row0 + ai * 128 + m * 16) * ldc + col0;
#pragma unroll
                for (int bj = 0; bj < 2; ++bj)
#pragma unroll
                    for (int n = 0; n < 2; ++n) *(f32x4*)(rowp + bj * 128 + n * 16) = acc[ai][bj][m][n]; }
    }
};
struct EpiSoftmaxP {
    bf16_t* P; LAS unsigned char* xl;
    __device__ __forceinline__ void operator()(const f32x4 (&acc)[2][2][4][2], const Unit& u, int wr, int wc, int fr, int fq) const {
        LAS float* mxs = (LAS float*)xl; LAS float* sms = mxs + 1024;
        const int rl0 = wr * 64 + fr;
        float rmax[2][4];
#pragma unroll
        for (int ai = 0; ai < 2; ++ai)
#pragma unroll
            for (int m = 0; m < 4; ++m) { float mx = -INFINITY;
#pragma unroll
                for (int bj = 0; bj < 2; ++bj)
#pragma unroll
                    for (int n = 0; n < 2; ++n) { const f32x4 v = acc[ai][bj][m][n]; mx = fmaxf(mx, fmaxf(fmaxf(v[0], v[1]), fmaxf(v[2], v[3]))); }
                mx = fmaxf(mx, __shfl_xor(mx, 16)); mx = fmaxf(mx, __shfl_xor(mx, 32));
                if (fq == 0) mxs[(rl0 + ai * 128 + m * 16) * 4 + wc] = mx; }
        asm volatile("s_waitcnt lgkmcnt(0)" ::: "memory"); __builtin_amdgcn_s_barrier(); asm volatile("" ::: "memory");
        float p[2][4][16];
#pragma unroll
        for (int ai = 0; ai < 2; ++ai)
#pragma unroll
            for (int m = 0; m < 4; ++m) { const f32x4 q = *(const LAS f32x4*)(mxs + (rl0 + ai * 128 + m * 16) * 4); const float mx = fmaxf(fmaxf(q[0], q[1]), fmaxf(q[2], q[3])); rmax[ai][m] = mx; float sm = 0.f;
#pragma unroll
                for (int bj = 0; bj < 2; ++bj)
#pragma unroll
                    for (int n = 0; n < 2; ++n)
#pragma unroll
                        for (int i = 0; i < 4; ++i) { const float e = __expf(acc[ai][bj][m][n][i] - mx); p[ai][m][bj * 8 + n * 4 + i] = e; sm += e; }
                sm += __shfl_xor(sm, 16); sm += __shfl_xor(sm, 32);
                if (fq == 0) sms[(rl0 + ai * 128 + m * 16) * 4 + wc] = sm; }
        asm volatile("s_waitcnt lgkmcnt(0)" ::: "memory"); __builtin_amdgcn_s_barrier(); asm volatile("" ::: "memory");
        const int row0 = u.pm * 256 + wr * 64 + fr, col0 = u.pn * 256 + wc * 32 + 4 * fq;
#pragma unroll
        for (int ai = 0; ai < 2; ++ai)
#pragma unroll
            for (int m = 0; m < 4; ++m) { const f32x4 q = *(const LAS f32x4*)(sms + (rl0 + ai * 128 + m * 16) * 4); const float inv = 1.0f / ((q[0] + q[1]) + (q[2] + q[3]));
                bf16_t* rowp = P + (size_t)(row0 + ai * 128 + m * 16) * 1024 + col0;
#pragma unroll
                for (int bj = 0; bj < 2; ++bj)
#pragma unroll
                    for (int n = 0; n < 2; ++n) { u32x2 w; w.x = cvt_pk_bf16(p[ai][m][bj * 8 + n * 4] * inv, p[ai][m][bj * 8 + n * 4 + 1] * inv); w.y = cvt_pk_bf16(p[ai][m][bj * 8 + n * 4 + 2] * inv, p[ai][m][bj * 8 + n * 4 + 3] * inv);
                        *(u32x2*)(rowp + bj * 128 + n * 16) = w; } }
        (void)rmax;
    }
};
struct EpiNormFused {
    const float* xin; float* xout; bf16_t* xn; const float* gpost; const float* gpre; float* part; unsigned* cnt; LAS unsigned char* xl;
    __device__ __forceinline__ float exchange(const float (&rowss)[2][4], int which, const Unit& u, int wr, int wc, int fr, int fq) const {
        LAS float* ps = (LAS float*)xl; LAS float* rs = ps + 1024;
        const int tid = (wr * 4 + wc) * 64 + fq * 16 + fr;
#pragma unroll
        for (int ai = 0; ai < 2; ++ai)
#pragma unroll
            for (int m = 0; m < 4; ++m) if (fq == 0) ps[(wr * 64 + fr + ai * 128 + m * 16) * 4 + wc] = rowss[ai][m];
        asm volatile("s_waitcnt lgkmcnt(0)" ::: "memory"); __builtin_amdgcn_s_barrier(); asm volatile("" ::: "memory");
        float* pp = part + (size_t)which * MTOK * 4; unsigned* cc = cnt + (which * 128 + u.pm) * 16;
        if (tid < 256) { const f32x4 q = *(const LAS f32x4*)(ps + tid * 4); const float tot = (q[0] + q[1]) + (q[2] + q[3]);
            __hip_atomic_store((unsigned*)(pp + ((size_t)u.pm * 256 + tid) * 4 + u.pn), __float_as_uint(tot), __ATOMIC_RELAXED, __HIP_MEMORY_SCOPE_AGENT); }
        asm volatile("s_waitcnt vmcnt(0)" ::: "memory"); __builtin_amdgcn_s_barrier(); asm volatile("" ::: "memory");
        if (tid == 0) (void)__hip_atomic_fetch_add(cc, 1u, __ATOMIC_RELAXED, __HIP_MEMORY_SCOPE_AGENT);
        if (tid < 64) { unsigned sp = 0; while ((unsigned)__builtin_amdgcn_readfirstlane((int)__hip_atomic_load(cc, __ATOMIC_RELAXED, __HIP_MEMORY_SCOPE_AGENT)) < 4u) { __builtin_amdgcn_s_sleep(1); if (++sp > (1u << 22)) break; } }
        asm volatile("" ::: "memory"); __builtin_amdgcn_s_barrier(); asm volatile("" ::: "memory");
        if (tid < 256) { const unsigned* gp = (const unsigned*)(pp + ((size_t)u.pm * 256 + tid) * 4);
            const float a = __uint_as_float(__hip_atomic_load(gp, __ATOMIC_RELAXED, __HIP_MEMORY_SCOPE_AGENT)), b = __uint_as_float(__hip_atomic_load(gp + 1, __ATOMIC_RELAXED, __HIP_MEMORY_SCOPE_AGENT)),
                        c = __uint_as_float(__hip_atomic_load(gp + 2, __ATOMIC_RELAXED, __HIP_MEMORY_SCOPE_AGENT)), d = __uint_as_float(__hip_atomic_load(gp + 3, __ATOMIC_RELAXED, __HIP_MEMORY_SCOPE_AGENT));
            rs[tid] = rsqrtf(((a + b) + (c + d)) * (1.0f / 1024.f) + EPS); }
        asm volatile("s_waitcnt lgkmcnt(0)" ::: "memory"); __builtin_amdgcn_s_barrier(); asm volatile("" ::: "memory");
        return 0.f;
    }
    __device__ __forceinline__ void operator()(const f32x4 (&acc)[2][2][4][2], const Unit& u, int wr, int wc, int fr, int fq) const {
        LAS float* rs = (LAS float*)xl + 1024;
        f32x4 y[2][2][4][2];
        float ss[2][4];
#pragma unroll
        for (int ai = 0; ai < 2; ++ai)
#pragma unroll
            for (int m = 0; m < 4; ++m) { float sacc = 0.f;
#pragma unroll
                for (int bj = 0; bj < 2; ++bj)
#pragma unroll
                    for (int n = 0; n < 2; ++n) { const f32x4 v = acc[ai][bj][m][n]; y[ai][bj][m][n] = v; sacc += (v[0] * v[0] + v[1] * v[1]) + (v[2] * v[2] + v[3] * v[3]); }
                sacc += __shfl_xor(sacc, 16); sacc += __shfl_xor(sacc, 32); ss[ai][m] = sacc; }
        (void)exchange(ss, 0, u, wr, wc, fr, fq);
        const int row0 = u.pm * 256 + wr * 64 + fr, col0 = u.pn * 256 + wc * 32 + 8 * fq;
#pragma unroll
        for (int ai = 0; ai < 2; ++ai)
#pragma unroll
            for (int m = 0; m < 4; ++m) { const int rl = wr * 64 + fr + ai * 128 + m * 16; const float r1 = rs[rl]; const size_t ro = (size_t)(row0 + ai * 128 + m * 16) * 1024; float sacc = 0.f;
#pragma unroll
                for (int bj = 0; bj < 2; ++bj)
#pragma unroll
                    for (int n = 0; n < 2; ++n) { const int c = col0 + bj * 128 + 4 * n; const f32x4 xv = *(const f32x4*)(xin + ro + c), gv = *(const f32x4*)(gpost + c);
                        const f32x4 v = xv + y[ai][bj][m][n] * r1 * gv; y[ai][bj][m][n] = v; *(f32x4*)(xout + ro + c) = v; sacc += (v[0] * v[0] + v[1] * v[1]) + (v[2] * v[2] + v[3] * v[3]); }
                sacc += __shfl_xor(sacc, 16); sacc += __shfl_xor(sacc, 32); ss[ai][m] = sacc; }
        if (!gpre) return;
        (void)exchange(ss, 1, u, wr, wc, fr, fq);
#pragma unroll
        for (int ai = 0; ai < 2; ++ai)
#pragma unroll
            for (int m = 0; m < 4; ++m) { const int rl = wr * 64 + fr + ai * 128 + m * 16; const float r2 = rs[rl]; const size_t ro = (size_t)(row0 + ai * 128 + m * 16) * 1024;
#pragma unroll
                for (int bj = 0; bj < 2; ++bj) { const int c = col0 + bj * 128; const f32x4 g0 = *(const f32x4*)(gpre + c), g1 = *(const f32x4*)(gpre + c + 4);
                    const f32x4 v0 = y[ai][bj][m][0] * r2 * g0, v1 = y[ai][bj][m][1] * r2 * g1;
                    u32x4 w; w.x = cvt_pk_bf16(v0[0], v0[1]); w.y = cvt_pk_bf16(v0[2], v0[3]); w.z = cvt_pk_bf16(v1[0], v1[1]); w.w = cvt_pk_bf16(v1[2], v1[3]);
                    *(u32x4*)(xn + ro + c) = w; } }
    }
};
struct EpiXKV {
    bf16_t* XK; bf16_t* XVT;
    __device__ __forceinline__ void operator()(const f32x4 (&acc)[2][2][4][2], const Unit& u, int wr, int wc, int fr, int fq) const {
        const int row0 = u.pm * 256 + wr * 64 + fr;
        if (u.pn < 4) { EpiPlain e{XK, 1024, 1.0f}; e(acc, u, wr, wc, fr, fq); return; }
        const int hx = u.pn - 4;
#pragma unroll
        for (int ai = 0; ai < 2; ++ai)
#pragma unroll
            for (int m = 0; m < 4; ++m) { const int r = row0 + ai * 128 + m * 16; const int lb = r >> 8, key = r & 255;
                bf16_t* base = XVT + ((size_t)(lb * 4 + hx) * 256) * 256 + key;
#pragma unroll
                for (int bj = 0; bj < 2; ++bj)
#pragma unroll
                    for (int n = 0; n < 2; ++n)
#pragma unroll
                        for (int i = 0; i < 4; ++i) { const int pos = bj * 128 + wc * 32 + 16 * n + 4 * fq + i; base[(size_t)pos * 256] = f2bf(acc[ai][bj][m][n][i]); } }
    }
};
struct EpiSwiGLU {
    bf16_t* F;
    __device__ __forceinline__ void operator()(const f32x4 (&acc)[2][2][4][2], const Unit& u, int wr, int wc, int fr, int fq) const {
        const int row0 = u.pm * 256 + wr * 64 + fr;
#pragma unroll
        for (int ai = 0; ai < 2; ++ai)
#pragma unroll
            for (int m = 0; m < 4; ++m) { bf16_t* rowp = F + (size_t)(row0 + ai * 128 + m * 16) * FF;
#pragma unroll
                for (int bj = 0; bj < 2; ++bj) { const int cc = 64 * (2 * u.pn + bj) + 16 * wc + 4 * fq; const f32x4 g = acc[ai][bj][m][0], up = acc[ai][bj][m][1]; float o[4];
#pragma unroll
                    for (int i = 0; i < 4; ++i) o[i] = g[i] * sigmoidf_(g[i]) * up[i];
                    u32x2 w; w.x = cvt_pk_bf16(o[0], o[1]); w.y = cvt_pk_bf16(o[2], o[3]); *(u32x2*)(rowp + cc) = w; } }
    }
};
struct EpiGates {
    bf16_t* Y; const bf16_t* ya; const bf16_t* yb; const float* gnorm; LAS unsigned char* xl;
    __device__ __forceinline__ void operator()(const f32x4 (&acc)[2][2][4][2], const Unit& u, int wr, int wc, int fr, int fq) const {
        LAS float* sms = (LAS float*)xl;
        const int row0 = u.pm * 256 + wr * 64 + fr, rl0 = wr * 64 + fr;
        u32x2 braw[2][4][2];
#pragma unroll
        for (int ai = 0; ai < 2; ++ai)
#pragma unroll
            for (int m = 0; m < 4; ++m) { const size_t r = (size_t)(row0 + ai * 128 + m * 16); float ss = 0.f;
#pragma unroll
                for (int bj = 0; bj < 2; ++bj) { const int cc = 64 * (2 * u.pn + bj) + 16 * wc + 4 * fq; const u32x2 b = *(const u32x2*)(yb + r * 1024 + cc); braw[ai][m][bj] = b;
                    const float b0 = bflo(b.x), b1 = bfhi(b.x), b2 = bflo(b.y), b3 = bfhi(b.y); ss += (b0 * b0 + b1 * b1) + (b2 * b2 + b3 * b3); }
                ss += __shfl_xor(ss, 16); ss += __shfl_xor(ss, 32);
                if (fq == 0) sms[(rl0 + ai * 128 + m * 16) * 4 + wc] = ss; }
        asm volatile("s_waitcnt lgkmcnt(0)" ::: "memory"); __builtin_amdgcn_s_barrier(); asm volatile("" ::: "memory");
#pragma unroll
        for (int ai = 0; ai < 2; ++ai)
#pragma unroll
            for (int m = 0; m < 4; ++m) { const size_t r = (size_t)(row0 + ai * 128 + m * 16);
                const f32x4 q = *(const LAS f32x4*)(sms + (rl0 + ai * 128 + m * 16) * 4); const float rs = rsqrtf(((q[0] + q[1]) + (q[2] + q[3])) * (1.0f / 128.f) + EPS);
#pragma unroll
                for (int bj = 0; bj < 2; ++bj) { const int cc = 64 * (2 * u.pn + bj) + 16 * wc + 4 * fq; const f32x4 ga = acc[ai][bj][m][0], gb = acc[ai][bj][m][1];
                    const u32x2 a = *(const u32x2*)(ya + r * 1024 + cc), b = braw[ai][m][bj]; const f32x4 gv = *(const f32x4*)(gnorm + (cc & 127));
                    const float av[4] = {bflo(a.x), bfhi(a.x), bflo(a.y), bfhi(a.y)}, bv[4] = {bflo(b.x), bfhi(b.x), bflo(b.y), bfhi(b.y)}; float o[4];
#pragma unroll
                    for (int i = 0; i < 4; ++i) o[i] = sigmoidf_(ga[i]) * av[i] + sigmoidf_(gb[i]) * (bv[i] * rs * gv[i]);
                    u32x2 w; w.x = cvt_pk_bf16(o[0], o[1]); w.y = cvt_pk_bf16(o[2], o[3]); *(u32x2*)(Y + r * 1024 + cc) = w; } }
    }
};
struct EpiInProj {
    KP e; int layer;
    __device__ __forceinline__ void operator()(const f32x4 (&acc)[2][2][4][2], const Unit& u, int wr, int wc, int fr, int fq) const {
        const int row0 = u.pm * 256 + wr * 64 + fr, pn = u.pn;
        if (pn == 5 || pn >= 8) {
            bf16_t* O = (pn == 5) ? e->vb : e->raw + (size_t)((pn - 8) >> 2) * MTOK * 1024 + ((pn - 8) & 3) * 256; const int ldc = (pn == 5) ? 256 : 1024;
#pragma unroll
            for (int ai = 0; ai < 2; ++ai)
#pragma unroll
                for (int m = 0; m < 4; ++m) { bf16_t* rowp = O + (size_t)(row0 + ai * 128 + m * 16) * ldc + wc * 32 + 8 * fq;
#pragma unroll
                    for (int bj = 0; bj < 2; ++bj) { const f32x4 v0 = acc[ai][bj][m][0], v1 = acc[ai][bj][m][1];
                        u32x4 w; w.x = cvt_pk_bf16(v0[0], v0[1]); w.y = cvt_pk_bf16(v0[2], v0[3]); w.z = cvt_pk_bf16(v1[0], v1[1]); w.w = cvt_pk_bf16(v1[2], v1[3]);
                        *(u32x4*)(rowp + bj * 128) = w;
                        if (m == 3 && fr >= 13 && pn >= 8 && pn < 16) {
                            const int r = row0 + ai * 128 + m * 16;
                            *(u32x4*)(e->halo + ((size_t)(r >> 6) * 3 + ((r & 63) - 61)) * 2048 + (pn - 8) * 256 + bj * 128 + wc * 32 + 8 * fq) = w; } } }
            return;
        }
        if (pn < 5) {
            const float sc = (pn < 4) ? 0.08838834764831845f : 1.0f; bf16_t* O = (pn < 4) ? e->qb : e->kb; const int ldc = (pn < 4) ? 1024 : 256; const int d0 = 16 * wc + 4 * fq;
#pragma unroll
            for (int ai = 0; ai < 2; ++ai)
#pragma unroll
                for (int m = 0; m < 4; ++m) { const size_t r = (size_t)(row0 + ai * 128 + m * 16);
                    const f32x4 c = *(const f32x4*)(e->rope_cos + r * 64 + d0), s = *(const f32x4*)(e->rope_sin + r * 64 + d0);
#pragma unroll
                    for (int bj = 0; bj < 2; ++bj) { const int head = (pn < 4) ? 2 * pn + bj : bj; const f32x4 x1 = acc[ai][bj][m][0], x2 = acc[ai][bj][m][1];
                        const f32x4 o1 = (x1 * c - x2 * s) * sc, o2 = (x2 * c + x1 * s) * sc;
                        u32x2 w1, w2; w1.x = cvt_pk_bf16(o1[0], o1[1]); w1.y = cvt_pk_bf16(o1[2], o1[3]); w2.x = cvt_pk_bf16(o2[0], o2[1]); w2.y = cvt_pk_bf16(o2[2], o2[3]);
                        *(u32x2*)(O + r * ldc + head * 128 + d0) = w1; *(u32x2*)(O + r * ldc + head * 128 + 64 + d0) = w2; } }
            return;
        }
        if (pn == 7 && wc >= 2) {
            if (wc == 2) {
#pragma unroll
                for (int ai = 0; ai < 2; ++ai)
#pragma unroll
                    for (int m = 0; m < 4; ++m) { const size_t r = (size_t)(row0 + ai * 128 + m * 16);
#pragma unroll
                        for (int n = 0; n < 2; ++n)
#pragma unroll
                            for (int i = 0; i < 4; ++i) { const int sidx = 16 * n + 4 * fq + i; const float v = acc[ai][0][m][n][i];
                                if (sidx < 4) e->wi[r * 4 + sidx] = v * 0.5f;
                                else if (sidx < 12) { const int h = sidx - 4; const float z = v + e->dt_bias[layer * 8 + h]; const float sp = fmaxf(z, 0.f) + __logf(1.0f + __expf(-fabsf(z))); e->gg[r * 8 + h] = -__expf(e->a_log[layer * 8 + h]) * sp; }
                                else if (sidx < 20) { const int h = sidx - 12; e->beta[r * 8 + h] = sigmoidf_(v); } } }
            }
            return;
        }
        const int d0 = 16 * (wc & 1) + 4 * fq;
#pragma unroll
        for (int ai = 0; ai < 2; ++ai)
#pragma unroll
            for (int m = 0; m < 4; ++m) { const size_t r = (size_t)(row0 + ai * 128 + m * 16);
                const f32x4 ca = *(const f32x4*)(e->rope_cos + r * 64 + 2 * d0), cb = *(const f32x4*)(e->rope_cos + r * 64 + 2 * d0 + 4);
                const f32x4 sa = *(const f32x4*)(e->rope_sin + r * 64 + 2 * d0), sb = *(const f32x4*)(e->rope_sin + r * 64 + 2 * d0 + 4);
                const f32x4 c = (f32x4){ca[0], ca[2], cb[0], cb[2]}, s = (f32x4){sa[0], sa[2], sb[0], sb[2]};
                if (pn == 6) {
#pragma unroll
                    for (int bj = 0; bj < 2; ++bj) { const int head = 2 * bj + (wc >> 1); const f32x4 x1 = acc[ai][bj][m][0], x2 = acc[ai][bj][m][1];
                        const f32x4 o1 = (x1 * c - x2 * s) * 0.125f, o2 = (x2 * c + x1 * s) * 0.125f;
                        u32x2 w1, w2; w1.x = cvt_pk_bf16(o1[0], o1[1]); w1.y = cvt_pk_bf16(o1[2], o1[3]); w2.x = cvt_pk_bf16(o2[0], o2[1]); w2.y = cvt_pk_bf16(o2[2], o2[3]);
                        *(u32x2*)(e->qib + r * 256 + head * 64 + d0) = w1; *(u32x2*)(e->qib + r * 256 + head * 64 + 32 + d0) = w2; }
                } else {
                    const f32x4 x1 = acc[ai][0][m][0], x2 = acc[ai][0][m][1];
                    const f32x4 o1 = x1 * c - x2 * s, o2 = x2 * c + x1 * s;
                    u32x2 w1, w2; w1.x = cvt_pk_bf16(o1[0], o1[1]); w1.y = cvt_pk_bf16(o1[2], o1[3]); w2.x = cvt_pk_bf16(o2[0], o2[1]); w2.y = cvt_pk_bf16(o2[2], o2[3]);
                    *(u32x2*)(e->kib + r * 64 + d0) = w1; *(u32x2*)(e->kib + r * 64 + 32 + d0) = w2;
                }
            }
    }
};

__device__ __forceinline__ void phase_gdn_prep(KP p, int layer, LAS unsigned char* lds) {
    const int tid = tid_opaque(), lane0 = tid & 63, wid = __builtin_amdgcn_readfirstlane(tid >> 6);
    LAS float* Ms = (LAS float*)(lds + wid * 16896);
    LAS float* gcs = Ms + 4096;
    const float* cw = p->conv_w + (size_t)layer * 4 * 3072;
    for (int item = blockIdx.x * NWAVES + wid; item < 4096; item += gridDim.x * NWAVES) {
        int lane = lane0; asm volatile("" : "+v"(lane));
        const int n = lane & 15, g = lane >> 4;
        const int c = item & 255, h = (item >> 8) & 7, b = item >> 11;
        const size_t m0 = (size_t)b * SEQ + 64 * c;
#pragma unroll 1
        for (int which = 0; which < 2; ++which) {
            bf16_t* rp = p->raw + (size_t)which * MTOK * 1024 + m0 * 1024 + h * 128 + 2 * lane;
            const int cc = which * 1024 + h * 128 + 2 * lane;
            float w[4][2];
#pragma unroll
            for (int j = 0; j < 4; ++j) { w[j][0] = cw[j * 3072 + cc]; w[j][1] = cw[j * 3072 + cc + 1]; }
            float hs[3][2];
#pragma unroll
            for (int j = 0; j < 3; ++j) { hs[j][0] = 0.f; hs[j][1] = 0.f; }
            if (c > 0) { const bf16_t* hp = p->halo + ((size_t)(m0 / 64 - 1) * 3) * 2048 + cc;
#pragma unroll
                for (int j = 0; j < 3; ++j) { const unsigned u = *(const unsigned*)(hp + j * 2048); hs[j][0] = bflo(u); hs[j][1] = bfhi(u); } }
            const float post = which == 0 ? 0.08838834764831845f : 1.0f;
            unsigned raw64[64];
#pragma unroll
            for (int r = 0; r < 64; ++r) raw64[r] = *(const unsigned*)(rp + (size_t)r * 1024);
#pragma unroll
            for (int r = 0; r < 64; ++r) {
                const float x0 = bflo(raw64[r]), x1 = bfhi(raw64[r]);
                float y0 = w[0][0] * hs[0][0] + w[1][0] * hs[1][0] + w[2][0] * hs[2][0] + w[3][0] * x0;
                float y1 = w[0][1] * hs[0][1] + w[1][1] * hs[1][1] + w[2][1] * hs[2][1] + w[3][1] * x1;
                hs[0][0] = hs[1][0]; hs[1][0] = hs[2][0]; hs[2][0] = x0; hs[0][1] = hs[1][1]; hs[1][1] = hs[2][1]; hs[2][1] = x1;
                y0 = y0 * sigmoidf_(y0); y1 = y1 * sigmoidf_(y1);
                const float ss = wave_sum(y0 * y0 + y1 * y1);
                const float rs = rsqrtf(ss + EPS) * post;
                *(unsigned*)(rp + (size_t)r * 1024) = cvt_pk_bf16(y0 * rs, y1 * rs);
            }
        }
        float gcv = p->gg[(m0 + lane) * 8 + h];
#pragma unroll
        for (int o = 1; o < 64; o <<= 1) { const float t = __shfl_up(gcv, o); if (lane >= o) gcv += t; }
        const float bev = p->beta[(m0 + lane) * 8 + h];
        p->gg[(m0 + lane) * 8 + h] = gcv;
        gcs[lane] = gcv; gcs[64 + lane] = bev;
        asm volatile("s_waitcnt vmcnt(0)" ::: "memory");
        bf16x8 kf[4][4];
        const bf16_t* kq = p->raw + m0 * 1024 + h * 128 + 8 * g + (size_t)n * 1024;
#pragma unroll
        for (int mt = 0; mt < 4; ++mt)
#pragma unroll
            for (int ks = 0; ks < 4; ++ks) kf[mt][ks] = *(const bf16x8*)(kq + (size_t)MTOK * 1024 + (size_t)mt * 16 * 1024 + 32 * ks);
        bf16_t* tout = (layer == 0 ? (bf16_t*)p->out : p->ta) + (size_t)item * 8192; bf16_t* aout = tout + 4096;
#pragma unroll
        for (int mt = 0; mt < 4; ++mt) {
            bf16x8 qf[4];
#pragma unroll
            for (int ks = 0; ks < 4; ++ks) qf[ks] = *(const bf16x8*)(kq + (size_t)mt * 16 * 1024 + 32 * ks);
            const f32x4 gi = *(const LAS f32x4*)(gcs + 16 * mt + 4 * g), bi = *(const LAS f32x4*)(gcs + 64 + 16 * mt + 4 * g);
#pragma unroll
            for (int nt = 0; nt < 4; ++nt) {
                f32x4 aK = (f32x4){0.f, 0.f, 0.f, 0.f}, aQ = (f32x4){0.f, 0.f, 0.f, 0.f};
                if (nt <= mt) {
#pragma unroll
                    for (int ks = 0; ks < 4; ++ks) { aK = __builtin_amdgcn_mfma_f32_16x16x32_bf16(kf[mt][ks], kf[nt][ks], aK, 0, 0, 0); aQ = __builtin_amdgcn_mfma_f32_16x16x32_bf16(qf[ks], kf[nt][ks], aQ, 0, 0, 0); }
                }
                const float gj = gcs[16 * nt + n]; const int j = 16 * nt + n;
#pragma unroll
                for (int r = 0; r < 4; ++r) { const int i = 16 * mt + 4 * g + r;
                    const float dec = (j <= i) ? __expf(gi[r] - gj) : 0.f;
                    Ms[i * 64 + j] = (j < i) ? bi[r] * aK[r] * dec : 0.f;
                    aout[i * 64 + j] = f2bf(aQ[r] * dec); }
            }
        }
        float Tc[64];
#pragma unroll
        for (int i = 0; i < 64; ++i) {
            float acc = (lane == i) ? 1.f : 0.f;
#pragma unroll
            for (int j4 = 0; j4 < i; j4 += 4) { const f32x4 mv = *(const LAS f32x4*)(Ms + i * 64 + j4);
#pragma unroll
                for (int jj = 0; jj < 4; ++jj) if (j4 + jj < i) acc -= mv[jj] * Tc[j4 + jj]; }
            Tc[i] = acc;
            tout[i * 64 + lane] = f2bf(acc);
            asm volatile("" ::: "memory");
        }
    }
}

__device__ __forceinline__ unsigned lds_addr32(LAS unsigned char* q) { return (unsigned)(unsigned long)q; }
__device__ __forceinline__ void glds16_asm(const void* gsrc, unsigned lds_dst) {
    unsigned keep; const unsigned dst = (unsigned)__builtin_amdgcn_readfirstlane((int)lds_dst);
    asm volatile("s_mov_b32 %0, m0\n\ts_mov_b32 m0, %2\n\ts_nop 0\n\tglobal_load_lds_dwordx4 %1, off\n\ts_mov_b32 m0, %0" : "=&s"(keep) : "v"(gsrc), "s"(dst) : "memory");
}
__device__ __forceinline__ void ds_read_b128_x2(u32x4& r0, u32x4& r1, unsigned a0, unsigned a1, const int off) {
    asm volatile("ds_read_b128 %0, %2 offset:%4\n\tds_read_b128 %1, %3 offset:%4\n\ts_waitcnt lgkmcnt(0)" : "=&v"(r0), "=&v"(r1) : "v"(a0), "v"(a1), "i"(off) : "memory");
}
__device__ __forceinline__ void glds16x2_s(const void* sbase, unsigned voff, unsigned lds_dst) {
    unsigned keep;
    asm volatile("s_mov_b32 %0, m0\n\ts_mov_b32 m0, %3\n\ts_nop 0\n\tglobal_load_lds_dwordx4 %1, %2\n\tglobal_load_lds_dwordx4 %1, %2 offset:1024\n\ts_mov_b32 m0, %0"
                 : "=&s"(keep) : "v"(voff), "s"(sbase), "s"(lds_dst) : "memory");
}
__device__ __forceinline__ void glds16_s2(const void* sa, const void* sb, unsigned voff, unsigned lds_a, unsigned lds_b) {
    unsigned keep;
    asm volatile("s_mov_b32 %0, m0\n\ts_mov_b32 m0, %4\n\ts_nop 0\n\tglobal_load_lds_dwordx4 %1, %2\n\ts_mov_b32 m0, %5\n\ts_nop 0\n\tglobal_load_lds_dwordx4 %1, %3\n\ts_mov_b32 m0, %0"
                 : "=&s"(keep) : "v"(voff), "s"(sa), "s"(sb), "s"(lds_a), "s"(lds_b) : "memory");
}
__device__ __forceinline__ void glds16_s4(const void* sbase, unsigned voff, unsigned lds_dst) {
    unsigned keep;
    asm volatile("s_mov_b32 %0, m0\n\ts_mov_b32 m0, %3\n\ts_nop 0\n\tglobal_load_lds_dwordx4 %1, %2\n\tglobal_load_lds_dwordx4 %1, %2 offset:1024\n\tglobal_load_lds_dwordx4 %1, %2 offset:2048\n\tglobal_load_lds_dwordx4 %1, %2 offset:3072\n\ts_mov_b32 m0, %0"
                 : "=&s"(keep) : "v"(voff), "s"(sbase), "s"(lds_dst) : "memory");
}
__device__ __forceinline__ void glds4_s2(const void* sa, const void* sb, unsigned voff, unsigned lds_a, unsigned lds_b) {
    unsigned keep;
    asm volatile("s_mov_b32 %0, m0\n\ts_mov_b32 m0, %4\n\ts_nop 0\n\tglobal_load_lds_dword %1, %2\n\ts_mov_b32 m0, %5\n\ts_nop 0\n\tglobal_load_lds_dword %1, %3\n\ts_mov_b32 m0, %0"
                 : "=&s"(keep) : "v"(voff), "s"(sa), "s"(sb), "s"(lds_a), "s"(lds_b) : "memory");
}
__device__ __forceinline__ void ds_read_tr16_b64_x8(u32x2 (&r)[8], const unsigned (&a)[8]) {
    asm volatile("ds_read_b64_tr_b16 %0, %8\n\tds_read_b64_tr_b16 %1, %9\n\tds_read_b64_tr_b16 %2, %10\n\tds_read_b64_tr_b16 %3, %11\n\t"
                 "ds_read_b64_tr_b16 %4, %12\n\tds_read_b64_tr_b16 %5, %13\n\tds_read_b64_tr_b16 %6, %14\n\tds_read_b64_tr_b16 %7, %15\n\ts_waitcnt lgkmcnt(0)"
                 : "=&v"(r[0]), "=&v"(r[1]), "=&v"(r[2]), "=&v"(r[3]), "=&v"(r[4]), "=&v"(r[5]), "=&v"(r[6]), "=&v"(r[7])
                 : "v"(a[0]), "v"(a[1]), "v"(a[2]), "v"(a[3]), "v"(a[4]), "v"(a[5]), "v"(a[6]), "v"(a[7]) : "memory");
}
__device__ __forceinline__ void ds_read_tr16_b64_x4(u32x2& r0, u32x2& r1, u32x2& r2, u32x2& r3, unsigned a0, unsigned a1, unsigned a2, unsigned a3) {
    asm volatile("ds_read_b64_tr_b16 %0, %4\n\tds_read_b64_tr_b16 %1, %5\n\tds_read_b64_tr_b16 %2, %6\n\tds_read_b64_tr_b16 %3, %7\n\ts_waitcnt lgkmcnt(0)"
                 : "=&v"(r0), "=&v"(r1), "=&v"(r2), "=&v"(r3) : "v"(a0), "v"(a1), "v"(a2), "v"(a3) : "memory");
}
constexpr int SC_K = 0, SC_Q = 16384, SC_T = 32768, SC_A = 40960, SC_S = 49152, SC_BUF = 49664;
constexpr int SC_VT = 2 * SC_BUF, SC_END = SC_VT + 2 * 4096;
constexpr unsigned SC_SPIN_CAP = 1u << 22;
#define SC_WAIT(flag, val) do { unsigned _sp = 0; while (*(flag) < (unsigned)(val) && ++_sp < SC_SPIN_CAP) __builtin_amdgcn_s_sleep(3); } while (0)
__device__ __forceinline__ void gdn_scan_issuer(KP p, int layer, int unit, LAS unsigned char* lds, int lane0, volatile LAS unsigned* f_dma, volatile LAS unsigned* f_done, unsigned fbase) {
    const int h = (unit >> 3) & 7, b = unit >> 6;
    const size_t mb = (size_t)b * SEQ;
    const bf16_t* rq = p->raw + h * 128; const bf16_t* rk = rq + (size_t)MTOK * 1024;
    const bf16_t* tab = (layer == 0 ? (const bf16_t*)p->out : p->ta) + (size_t)((b * 8 + h) * 256) * 8192;
    unsigned vo_kq[4];
#pragma unroll
    for (int j = 0; j < 4; ++j) vo_kq[j] = (unsigned)((lane0 >> 4) * 2048 + 16 * ((lane0 & 15) ^ ((4 * j + (lane0 >> 4)) & 15)));
    const unsigned vo_ta = (unsigned)((lane0 >> 3) * 128 + 16 * ((lane0 & 7) ^ ((lane0 >> 3) & 7))), vo_g = (unsigned)(lane0 * 32);
    const unsigned ldsS = (unsigned)__builtin_amdgcn_readfirstlane((int)lds_addr32(lds));
    for (int c = 0; c < 256; ++c) {
        if (c >= 2) SC_WAIT(f_done, fbase + c - 1);
        const size_t m0 = mb + 64 * (size_t)c; const unsigned l_ = ldsS + (c & 1) * SC_BUF;
        const char* sk = (const char*)(rk + m0 * 1024); const char* sq = (const char*)(rq + m0 * 1024);
#pragma unroll
        for (int i = 0; i < 16; ++i) glds16_s2(sk + i * 8192, sq + i * 8192, vo_kq[i & 3], l_ + SC_K + i * 1024, l_ + SC_Q + i * 1024);
        { const char* t = (const char*)(tab + (size_t)c * 8192);
          glds16_s4(t, vo_ta, l_ + SC_T); glds16_s4(t + 4096, vo_ta, l_ + SC_T + 4096); glds16_s4(t + 8192, vo_ta, l_ + SC_A); glds16_s4(t + 12288, vo_ta, l_ + SC_A + 4096); }
        glds4_s2(p->gg + m0 * 8 + h, p->beta + m0 * 8 + h, vo_g, l_ + SC_S, l_ + SC_S + 256);
        asm volatile("s_waitcnt vmcnt(0)" ::: "memory");
        *f_dma = fbase + (unsigned)c + 1u;
    }
}
__device__ __forceinline__ void gdn_scan_conv(KP p, int layer, int unit, LAS unsigned char* lds, int lane0, volatile LAS unsigned* f_dma, volatile LAS unsigned* f_vr, volatile LAS unsigned* f_done, unsigned fbase) {
    const int n = lane0 & 15, g = lane0 >> 4;
    const int cb = unit & 7, h = (unit >> 3) & 7, b = unit >> 6;
    const size_t mb = (size_t)b * SEQ;
    const bf16_t* rv = p->raw + (size_t)MTOK * 2048 + h * 128 + 16 * cb + n;
    const float* cw = p->conv_w + (size_t)layer * 4 * 3072 + 2048 + h * 128 + 16 * cb + n;
    const float wv0 = cw[0], wv1 = cw[3072], wv2 = cw[2 * 3072], wv3 = cw[3 * 3072];
    unsigned short xn[4][7];
    float pv[3] = {0.f, 0.f, 0.f};
#define SCV_LOAD(c) do { const size_t _m0 = mb + 64 * (size_t)(c); _Pragma("unroll") for (int _mt = 0; _mt < 4; ++_mt) _Pragma("unroll") for (int _k = 0; _k < 7; ++_k) { \
        const int _tok = 16 * _mt + 4 * g - 3 + _k; xn[_mt][_k] = rv[(_m0 + (size_t)(_tok < 0 ? 0 : _tok)) * 1024]; } } while (0)
    SCV_LOAD(0);
    for (int c = 0; c < 256; ++c) {
        float x[4][7];
#pragma unroll
        for (int mt = 0; mt < 4; ++mt)
#pragma unroll
            for (int k = 0; k < 7; ++k) x[mt][k] = bf2f(xn[mt][k]);
        asm volatile("" ::: "memory");
        if (c + 1 < 256) SCV_LOAD(c + 1);
#pragma unroll
        for (int k = 0; k < 3; ++k) if (4 * g - 3 + k < 0) x[0][k] = pv[k];
        f32x4 vt[4];
#pragma unroll
        for (int mt = 0; mt < 4; ++mt)
#pragma unroll
            for (int r = 0; r < 4; ++r) { const float y = wv0 * x[mt][r] + wv1 * x[mt][r + 1] + wv2 * x[mt][r + 2] + wv3 * x[mt][r + 3]; vt[mt][r] = y * sigmoidf_(y); }
#pragma unroll
        for (int k = 0; k < 3; ++k) pv[k] = __shfl(x[3][4 + k], 48 + n);
        if (c >= 2) SC_WAIT(f_done, fbase + c - 1);
        LAS unsigned char* slot = lds + SC_VT + (c & 1) * 4096;
#pragma unroll
        for (int mt = 0; mt < 4; ++mt) *(LAS f32x4*)(slot + ((mt * 4 + g) * 16 + n) * 16) = vt[mt];
        asm volatile("s_waitcnt lgkmcnt(0)" ::: "memory");
        SC_WAIT(f_dma, fbase + c + 1);
        *f_vr = fbase + (unsigned)c + 1u;
    }
#undef SCV_LOAD
}
__device__ __forceinline__ void gdn_scan_unit(KP p, int unit, LAS unsigned char* lds, int lane0, volatile LAS unsigned* f_vr, volatile LAS unsigned* f_done, unsigned fbase) {
    int lane = lane0; const int n = lane0 & 15, g = lane0 >> 4;
    const int cb = unit & 7, h = (unit >> 3) & 7, b = unit >> 6;
    const size_t mb = (size_t)b * SEQ;
    bf16_t* rv = p->raw + (size_t)MTOK * 2048 + h * 128 + 16 * cb;
    f32x4 S[8];
#pragma unroll
    for (int t = 0; t < 8; ++t) S[t] = (f32x4){0.f, 0.f, 0.f, 0.f};
    for (int c = 0; c < 256; ++c) {
        const int buf = c & 1; LAS unsigned char* L = lds + buf * SC_BUF;
        asm volatile("" : "+v"(lane));
        SC_WAIT(f_vr, fbase + c + 1);
        asm volatile("" ::: "memory");
        const float gcl = ((const LAS float*)(L + SC_S))[63];
        f32x4 vt[4];
        { const LAS unsigned char* slot = lds + SC_VT + buf * 4096;
#pragma unroll
          for (int mt = 0; mt < 4; ++mt) vt[mt] = *(const LAS f32x4*)(slot + ((mt * 4 + g) * 16 + n) * 16); }
        bf16x8 bS[4];
#pragma unroll
        for (int ks = 0; ks < 4; ++ks) { u32x4 w; w.x = cvt_pk_bf16(S[2 * ks][0], S[2 * ks][1]); w.y = cvt_pk_bf16(S[2 * ks][2], S[2 * ks][3]); w.z = cvt_pk_bf16(S[2 * ks + 1][0], S[2 * ks + 1][1]); w.w = cvt_pk_bf16(S[2 * ks + 1][2], S[2 * ks + 1][3]); bS[ks] = __builtin_bit_cast(bf16x8, w); }
#define SC_AFRAG128(IMG, mt, ks) ({ const int _row = 16 * (mt) + n; const LAS unsigned char* _b = L + (IMG) + _row * 256 + 8 * (g & 1); \
        const u32x2 _lo = *(const LAS u32x2*)(_b + 16 * ((4 * (ks) + (g >> 1)) ^ (_row & 15))), _hi = *(const LAS u32x2*)(_b + 16 * ((4 * (ks) + 2 + (g >> 1)) ^ (_row & 15))); \
        __builtin_bit_cast(bf16x8, (u32x4){_lo.x, _lo.y, _hi.x, _hi.y}); })
#define SC_AFRAG64(IMG, mt, ks) ({ const int _row = 16 * (mt) + n; const LAS unsigned char* _b = L + (IMG) + _row * 128 + 8 * (g & 1); \
        const u32x2 _lo = *(const LAS u32x2*)(_b + 16 * ((4 * (ks) + (g >> 1)) ^ (_row & 7))), _hi = *(const LAS u32x2*)(_b + 16 * ((4 * (ks) + 2 + (g >> 1)) ^ (_row & 7))); \
        __builtin_bit_cast(bf16x8, (u32x4){_lo.x, _lo.y, _hi.x, _hi.y}); })
        f32x4 KS[4], QS[4];
#pragma unroll
        for (int mt = 0; mt < 4; ++mt) { KS[mt] = (f32x4){0.f, 0.f, 0.f, 0.f}; QS[mt] = (f32x4){0.f, 0.f, 0.f, 0.f};
#pragma unroll
            for (int ks = 0; ks < 4; ++ks) { KS[mt] = __builtin_amdgcn_mfma_f32_16x16x32_bf16(SC_AFRAG128(SC_K, mt, ks), bS[ks], KS[mt], 0, 0, 0); QS[mt] = __builtin_amdgcn_mfma_f32_16x16x32_bf16(SC_AFRAG128(SC_Q, mt, ks), bS[ks], QS[mt], 0, 0, 0); } }
        f32x4 eg[4];
        bf16x8 bR[2];
        { f32x4 Rb[4];
#pragma unroll
          for (int mt = 0; mt < 4; ++mt) { const f32x4 gc4 = *(const LAS f32x4*)(L + SC_S + 4 * (16 * mt + 4 * g)), be4 = *(const LAS f32x4*)(L + SC_S + 256 + 4 * (16 * mt + 4 * g));
#pragma unroll
              for (int r = 0; r < 4; ++r) { eg[mt][r] = __expf(gc4[r]); Rb[mt][r] = be4[r] * (vt[mt][r] - eg[mt][r] * KS[mt][r]); QS[mt][r] *= eg[mt][r]; } }
#pragma unroll
          for (int ks = 0; ks < 2; ++ks) { u32x4 w; w.x = cvt_pk_bf16(Rb[2 * ks][0], Rb[2 * ks][1]); w.y = cvt_pk_bf16(Rb[2 * ks][2], Rb[2 * ks][3]); w.z = cvt_pk_bf16(Rb[2 * ks + 1][0], Rb[2 * ks + 1][1]); w.w = cvt_pk_bf16(Rb[2 * ks + 1][2], Rb[2 * ks + 1][3]); bR[ks] = __builtin_bit_cast(bf16x8, w); } }
        f32x4 vn[4];
#pragma unroll
        for (int mt = 0; mt < 4; ++mt) { vn[mt] = (f32x4){0.f, 0.f, 0.f, 0.f};
#pragma unroll
            for (int ks = 0; ks < 2; ++ks) vn[mt] = __builtin_amdgcn_mfma_f32_16x16x32_bf16(SC_AFRAG64(SC_T, mt, ks), bR[ks], vn[mt], 0, 0, 0); }
        bf16x8 bV[2], bVS[2];
#pragma unroll
        for (int ks = 0; ks < 2; ++ks) { u32x4 w; w.x = cvt_pk_bf16(vn[2 * ks][0], vn[2 * ks][1]); w.y = cvt_pk_bf16(vn[2 * ks][2], vn[2 * ks][3]); w.z = cvt_pk_bf16(vn[2 * ks + 1][0], vn[2 * ks + 1][1]); w.w = cvt_pk_bf16(vn[2 * ks + 1][2], vn[2 * ks + 1][3]); bV[ks] = __builtin_bit_cast(bf16x8, w);
            const f32x4 ga = *(const LAS f32x4*)(L + SC_S + 4 * (32 * ks + 4 * g)), gb2 = *(const LAS f32x4*)(L + SC_S + 4 * (32 * ks + 16 + 4 * g));
            f32x4 ea, eb;
#pragma unroll
            for (int r = 0; r < 4; ++r) { ea[r] = vn[2 * ks][r] * __expf(gcl - ga[r]); eb[r] = vn[2 * ks + 1][r] * __expf(gcl - gb2[r]); }
            u32x4 z; z.x = cvt_pk_bf16(ea[0], ea[1]); z.y = cvt_pk_bf16(ea[2], ea[3]); z.z = cvt_pk_bf16(eb[0], eb[1]); z.w = cvt_pk_bf16(eb[2], eb[3]); bVS[ks] = __builtin_bit_cast(bf16x8, z); }
        { const size_t m0 = mb + 64 * (size_t)c;
#pragma unroll
          for (int mt = 0; mt < 4; ++mt) {
#pragma unroll
              for (int ks = 0; ks < 2; ++ks) QS[mt] = __builtin_amdgcn_mfma_f32_16x16x32_bf16(SC_AFRAG64(SC_A, mt, ks), bV[ks], QS[mt], 0, 0, 0);
#pragma unroll
              for (int r = 0; r < 4; ++r) rv[(m0 + 16 * mt + 4 * g + r) * 1024 + n] = f2bf(QS[mt][r]); } }
        { const float egl = __expf(gcl); const int q4 = (lane & 15) >> 2, p4 = lane & 3; const unsigned kbase = lds_addr32(L + SC_K) + 8 * (p4 & 1);
#pragma unroll
          for (int t = 0; t < 8; t += 2) {
              u32x2 f[8]; unsigned fa[8];
#pragma unroll
              for (int tt = 0; tt < 2; ++tt)
#pragma unroll
                  for (int ks = 0; ks < 2; ++ks)
#pragma unroll
                      for (int u = 0; u < 2; ++u) { const int row = 32 * ks + 16 * u + 4 * g + q4; fa[tt * 4 + ks * 2 + u] = kbase + row * 256 + 16 * ((2 * (t + tt) + (p4 >> 1)) ^ (row & 15)); }
              ds_read_tr16_b64_x8(f, fa);
#pragma unroll
              for (int tt = 0; tt < 2; ++tt) {
                  S[t + tt] = S[t + tt] * egl;
#pragma unroll
                  for (int ks = 0; ks < 2; ++ks) S[t + tt] = __builtin_amdgcn_mfma_f32_16x16x32_bf16(__builtin_bit_cast(bf16x8, (u32x4){f[tt * 4 + ks * 2].x, f[tt * 4 + ks * 2].y, f[tt * 4 + ks * 2 + 1].x, f[tt * 4 + ks * 2 + 1].y}), bVS[ks], S[t + tt], 0, 0, 0);
              }
          } }
        asm volatile("s_waitcnt lgkmcnt(0)" ::: "memory");
        *f_done = fbase + (unsigned)c + 1u;
    }
#undef SC_AFRAG128
#undef SC_AFRAG64
}


constexpr int SA_LDS_WAVE = 16384;
template <bool DB> __device__ __forceinline__ void phase_sparse_attn(KP p, unsigned* counter, unsigned qx, LAS unsigned char* wl, int lane) {
    const int n = lane & 15, gq = lane >> 4, q4 = n >> 2, p4 = n & 3;
    constexpr unsigned NITEMS = (unsigned)(MTOK * 2);
    unsigned raw = 0;
    if (lane == 0) raw = __hip_atomic_fetch_add(counter, 1u, __ATOMIC_RELAXED, __HIP_MEMORY_SCOPE_AGENT);
    unsigned it = (unsigned)__builtin_amdgcn_readfirstlane((int)raw) * 32u + qx;
    if (it >= NITEMS) return;
    if (lane == 0) raw = __hip_atomic_fetch_add(counter, 1u, __ATOMIC_RELAXED, __HIP_MEMORY_SCOPE_AGENT);
    const bf16_t* selrow; const bf16_t* kbase; const bf16_t* vbase; bf16_t* qrow;
#define SA_DECODE(IT) do { const int _bg = (int)((IT) / SEQ), _t = (int)((IT) % SEQ), _b = _bg >> 1, _gk = _bg & 1; const size_t _m = (size_t)_b * SEQ + _t; \
        selrow = p->sel + _m * TOPK; kbase = p->kb + (size_t)_b * SEQ * 256 + _gk * 128 + 8 * gq; vbase = p->vb + (size_t)_b * SEQ * 256 + _gk * 128; qrow = p->qb + _m * 1024 + _gk * 512; } while (0)
#define SA_ISSUE_V(c, BUF) do { LAS unsigned char* _d = wl + (BUF) * 8192; \
        _Pragma("unroll") for (int _i = 0; _i < 8; ++_i) { const int _r = 4 * _i + gq; unsigned _s = selrow[32 * (c) + _r]; _s = (_s == 0xFFFFu) ? 0u : _s; \
            __builtin_amdgcn_global_load_lds((const unsigned*)(vbase + (size_t)_s * 256 + 8 * (n ^ (_r & 15))), (LAS unsigned*)(_d + _i * 1024), 16, 0, 0); } } while (0)
#define SA_LOAD_SKQ() do { _Pragma("unroll") for (int _kt = 0; _kt < 16; _kt += 2) { unsigned _t0 = selrow[16 * _kt + n], _t1 = selrow[16 * _kt + 16 + n]; _t0 = (_t0 == 0xFFFFu) ? 0u : _t0; _t1 = (_t1 == 0xFFFFu) ? 0u : _t1; sk[_kt >> 1] = _t0 | (_t1 << 16); } \
        _Pragma("unroll") for (int _ks = 0; _ks < 4; ++_ks) { u32x4 _w = (u32x4){0u, 0u, 0u, 0u}; if (n < 4) _w = __builtin_nontemporal_load((const u32x4*)(qrow + n * 128 + 32 * _ks + 8 * gq)); bQ[_ks] = __builtin_bit_cast(bf16x8, _w); } } while (0)
#define SA_LOADK(kt) do { const bf16_t* _kr = kbase + (size_t)(((kt) & 1) ? (sk[(kt) >> 1] >> 16) : (sk[(kt) >> 1] & 0xffffu)) * 256; _Pragma("unroll") for (int _ks = 0; _ks < 4; ++_ks) kf[(kt) % 3][_ks] = *(const bf16x8*)(_kr + 32 * _ks); } while (0)
#define SA_FENCE() asm volatile("" ::: "memory")
    unsigned sk[8]; bf16x8 bQ[4]; bf16x8 kf[3][4];
    SA_DECODE(it);
    SA_ISSUE_V(0, 0); if (DB) SA_ISSUE_V(1, 1);
    SA_FENCE(); SA_LOAD_SKQ(); SA_LOADK(0); SA_LOADK(1); SA_LOADK(2); SA_FENCE();
    for (;;) {
        f32x4 ST[16];
        float mx = -INFINITY;
#pragma unroll
        for (int kt = 0; kt < 16; ++kt) {
            f32x4 acc = (f32x4){0.f, 0.f, 0.f, 0.f};
#pragma unroll
            for (int ks = 0; ks < 4; ++ks) acc = __builtin_amdgcn_mfma_f32_16x16x32_bf16(kf[kt % 3][ks], bQ[ks], acc, 0, 0, 0);
            if (kt + 3 < 16) SA_LOADK(kt + 3);
            const u32x2 sv = *(const u32x2*)(selrow + 16 * kt + 4 * gq);
            const bool v0 = (sv.x & 0xffffu) != 0xffffu, v1 = (sv.x >> 16) != 0xffffu, v2 = (sv.y & 0xffffu) != 0xffffu, v3 = (sv.y >> 16) != 0xffffu;
            acc[0] = v0 ? acc[0] : -INFINITY; acc[1] = v1 ? acc[1] : -INFINITY; acc[2] = v2 ? acc[2] : -INFINITY; acc[3] = v3 ? acc[3] : -INFINITY;
            ST[kt] = acc; mx = fmaxf(fmaxf(mx, fmaxf(acc[0], acc[1])), fmaxf(acc[2], acc[3]));
        }
        mx = fmaxf(mx, __shfl_xor(mx, 16)); mx = fmaxf(mx, __shfl_xor(mx, 32));
        float sum = 0.f;
#pragma unroll
        for (int kt = 0; kt < 16; ++kt)
#pragma unroll
            for (int r = 0; r < 4; ++r) { const float e = __expf(ST[kt][r] - mx); ST[kt][r] = e; sum += e; }
        sum += __shfl_xor(sum, 16); sum += __shfl_xor(sum, 32);
        const float inv = 1.0f / sum;
        bf16_t* const qcur = qrow; const bf16_t* const selcur = selrow; const bf16_t* const vcur = vbase;
        const unsigned nxt = (unsigned)__builtin_amdgcn_readfirstlane((int)raw) * 32u + qx;
        const bool valid = nxt < NITEMS;
        if (valid) { if (lane == 0) raw = __hip_atomic_fetch_add(counter, 1u, __ATOMIC_RELAXED, __HIP_MEMORY_SCOPE_AGENT); }
        SA_FENCE();
        if (valid) { SA_DECODE(nxt); SA_LOAD_SKQ(); }
        SA_FENCE();
        f32x4 OT[8];
#pragma unroll
        for (int dt = 0; dt < 8; ++dt) OT[dt] = (f32x4){0.f, 0.f, 0.f, 0.f};
#pragma unroll
        for (int c = 0; c < 8; ++c) {
            if (DB) { if (c <= 1) { if (valid) asm volatile("s_waitcnt vmcnt(21)" ::: "memory"); else asm volatile("s_waitcnt vmcnt(0)" ::: "memory"); }
                      else if (c <= 4) asm volatile("s_waitcnt vmcnt(8)" ::: "memory");
                      else if (c <= 6) { if (valid) asm volatile("s_waitcnt vmcnt(20)" ::: "memory"); else asm volatile("s_waitcnt vmcnt(8)" ::: "memory"); }
                      else { if (valid) asm volatile("s_waitcnt vmcnt(8)" ::: "memory"); else asm volatile("s_waitcnt vmcnt(0)" ::: "memory"); } }
            else { if (c == 5 && valid) asm volatile("s_waitcnt vmcnt(12)" ::: "memory"); else asm volatile("s_waitcnt vmcnt(0)" ::: "memory"); }
            u32x4 w; w.x = cvt_pk_bf16(ST[2 * c][0], ST[2 * c][1]); w.y = cvt_pk_bf16(ST[2 * c][2], ST[2 * c][3]); w.z = cvt_pk_bf16(ST[2 * c + 1][0], ST[2 * c + 1][1]); w.w = cvt_pk_bf16(ST[2 * c + 1][2], ST[2 * c + 1][3]);
            const bf16x8 bP = __builtin_bit_cast(bf16x8, w);
            const unsigned vb0 = lds_addr32(wl + (DB ? (c & 1) * 8192 : 0)) + 8 * (p4 & 1);
#pragma unroll
            for (int dt = 0; dt < 8; dt += 2) {
                u32x2 f00, f01, f10, f11;
                const int r0 = 4 * gq + q4, r1 = 16 + 4 * gq + q4;
                ds_read_tr16_b64_x4(f00, f01, f10, f11,
                    vb0 + r0 * 256 + 16 * ((2 * dt + (p4 >> 1)) ^ (r0 & 15)), vb0 + r1 * 256 + 16 * ((2 * dt + (p4 >> 1)) ^ (r1 & 15)),
                    vb0 + r0 * 256 + 16 * ((2 * dt + 2 + (p4 >> 1)) ^ (r0 & 15)), vb0 + r1 * 256 + 16 * ((2 * dt + 2 + (p4 >> 1)) ^ (r1 & 15)));
                OT[dt] = __builtin_amdgcn_mfma_f32_16x16x32_bf16(__builtin_bit_cast(bf16x8, (u32x4){f00.x, f00.y, f01.x, f01.y}), bP, OT[dt], 0, 0, 0);
                OT[dt + 1] = __builtin_amdgcn_mfma_f32_16x16x32_bf16(__builtin_bit_cast(bf16x8, (u32x4){f10.x, f10.y, f11.x, f11.y}), bP, OT[dt + 1], 0, 0, 0);
            }
            SA_FENCE();
            { const bf16_t* const seln = selrow; const bf16_t* const vn_ = vbase;
              if (DB) { if (c + 2 < 8) { selrow = selcur; vbase = vcur; SA_ISSUE_V(c + 2, c & 1); selrow = seln; vbase = vn_; } else if (valid) SA_ISSUE_V(c - 6, c & 1); }
              else    { if (c + 1 < 8) { selrow = selcur; vbase = vcur; SA_ISSUE_V(c + 1, 0); selrow = seln; vbase = vn_; } else if (valid) SA_ISSUE_V(0, 0); } }
            SA_FENCE();
            if (c == 4 && valid) { SA_LOADK(0); SA_LOADK(1); SA_LOADK(2); SA_FENCE(); }
        }
        if (n < 4) {
#pragma unroll
            for (int dt = 0; dt < 8; ++dt) { u32x2 w; w.x = cvt_pk_bf16(OT[dt][0] * inv, OT[dt][1] * inv); w.y = cvt_pk_bf16(OT[dt][2] * inv, OT[dt][3] * inv); __builtin_nontemporal_store(w, (u32x2*)(qcur + n * 128 + 16 * dt + 4 * gq)); }
        }
        if (!valid) break;
        it = nxt;
    }
#undef SA_DECODE
#undef SA_ISSUE_V
#undef SA_LOAD_SKQ
#undef SA_LOADK
#undef SA_FENCE
}

#define SEL_DPP(v, ctrl, rowmask) ((unsigned)__builtin_amdgcn_update_dpp(0, (int)(v), (ctrl), (rowmask), 0xf, false))
__device__ __forceinline__ unsigned row_incl_scan(unsigned v) { v += SEL_DPP(v, 0x111, 0xf); v += SEL_DPP(v, 0x112, 0xf); v += SEL_DPP(v, 0x114, 0xf); v += SEL_DPP(v, 0x118, 0xf); return v; }
__device__ __forceinline__ unsigned wave_incl_scan(unsigned v) { v = row_incl_scan(v); v += SEL_DPP(v, 0x142, 0xa); v += SEL_DPP(v, 0x143, 0xc); return v; }
__device__ __forceinline__ unsigned row_min_all(unsigned v) { v = min(v, SEL_DPP(v, 0xB1, 0xf)); v = min(v, SEL_DPP(v, 0x4E, 0xf)); v = min(v, SEL_DPP(v, 0x141, 0xf)); v = min(v, SEL_DPP(v, 0x140, 0xf)); return v; }
__device__ __forceinline__ unsigned row_max_all(unsigned v) { v = max(v, SEL_DPP(v, 0xB1, 0xf)); v = max(v, SEL_DPP(v, 0x4E, 0xf)); v = max(v, SEL_DPP(v, 0x141, 0xf)); v = max(v, SEL_DPP(v, 0x140, 0xf)); return v; }
template <int FB> __device__ __forceinline__ unsigned sel_bin(unsigned d) { return ((d & ((1u << FB) - 1u)) << 6) | (d >> FB); }
template <int FB> __device__ __forceinline__ void sel_find_bin(const LAS unsigned* h, unsigned need, LAS unsigned* out, LAS unsigned* out2, LAS unsigned* tie, int lane) {
    const int rl = 63 - lane;
    unsigned c = 0;
#pragma unroll
    for (int k = 0; k < (1 << FB); ++k) c += h[k * 64 + rl];
    const unsigned incl = wave_incl_scan(c);
    const unsigned above = incl - c;
    const unsigned long long m = __ballot(above < need && need <= incl);
    if (m == 0ull) return;
    const int hl = __builtin_ctzll(m);
    const unsigned hg = (unsigned)(63 - hl);
    const unsigned need2 = need - (unsigned)__builtin_amdgcn_readlane((int)above, hl);
    const int fb = (1 << FB) - 1 - lane;
    const unsigned f = lane < (1 << FB) ? h[fb * 64 + hg] : 0u;
    const unsigned incl2 = wave_incl_scan(f);
    const unsigned above2 = incl2 - f;
    if (above2 < need2 && need2 <= incl2) { out[0] = (hg << FB) + (unsigned)fb; out[1] = need2 - above2; if (out2) *out2 = f; if (tie && f > need2 - above2) *tie = 1u; }
}
#define SEL_BIN(d) sel_bin<6>(d)
__device__ __forceinline__ void phase_dsa_select(KP p, LAS unsigned char* lds) {
    const int tid = tid_opaque(), lane0 = tid & 63, wid0 = __builtin_amdgcn_readfirstlane(tid >> 6);
    LAS unsigned* hist = (LAS unsigned*)lds;
    LAS unsigned short* cntG = (LAS unsigned short*)(lds + 65536);
    LAS unsigned short* cntE = cntG + 4096;
    LAS unsigned* ctl = (LAS unsigned*)(lds + 131072);
    const int xcd = blockIdx.x & 7, b = xcd >> 2, lb = (blockIdx.x >> 3) * 4 + (xcd & 3);
    const int nlb = (gridDim.x >> 3) * 4;
    for (int gi = lb; gi < SEQ / 4; gi += nlb) {
        const int t0 = 4 * gi; const size_t mq0 = (size_t)b * SEQ + t0;
        int lane = lane0, wid = wid0; asm volatile("" : "+v"(lane), "+s"(wid));
        const int n = lane & 15, gq = lane >> 4;
        if (t0 + 4 <= TOPK) {
            const int tidp = wid * 64 + lane; const int q = tidp >> 7, i = (tidp & 127) * 2, t = t0 + q;
            *(unsigned*)(p->sel + (mq0 + q) * TOPK + i) = (unsigned)(i <= t ? i : 0xFFFF) | ((unsigned)(i + 1 <= t ? i + 1 : 0xFFFF) << 16);
            continue;
        }
        const int NT = (t0 + 3) / 16 + 1;
        bf16x8 aq[2];
#pragma unroll
        for (int ks = 0; ks < 2; ++ks) aq[ks] = *(const bf16x8*)(p->qib + (mq0 + (n >> 2)) * 256 + (n & 3) * 64 + 32 * ks + 8 * gq);
        const f32x4 w4 = *(const f32x4*)(p->wi + (mq0 + gq) * 4);
        const int tq = t0 + gq;
        const int nj = (NT - wid + 7) >> 3;
        const int NB = (nj + 1) >> 1;
        LAS unsigned char* ring = lds + wid * 16384; const unsigned ring32 = lds_addr32(ring);
        const bf16_t* kib0 = p->kib + (size_t)b * SEQ * 64;
        const int dk = lane >> 3, dc = (lane & 7);
        const unsigned dvoff = (unsigned)(dk * 128 + 16 * (dc ^ (dk & 7)));
        const unsigned ringS = (unsigned)__builtin_amdgcn_readfirstlane((int)ring32);
#define SEL_ISSUE(blk) do { _Pragma("unroll") for (int _jj = 0; _jj < 2; ++_jj) { int _tile = 8 * (2 * (blk) + _jj) + wid; _tile = _tile < NT ? _tile : NT - 1; \
            glds16x2_s(kib0 + (size_t)_tile * 1024, dvoff, ringS + (((blk) & 3) * 2 + _jj) * 2048); } } while (0)
        unsigned mk[128];
        unsigned m1 = 0u, m2 = 0u;
        SEL_ISSUE(0); SEL_ISSUE(1); SEL_ISSUE(2);
        asm volatile("" :: "v"(aq[0]), "v"(aq[1]), "v"(w4));
        const unsigned ra0 = ring32 + n * 128 + 16 * (gq ^ (n & 7)), ra1 = ring32 + n * 128 + 16 * ((4 + gq) ^ (n & 7));
#pragma unroll
        for (int blk = 0; blk < 64; ++blk) {
            if (blk < NB) {
                SEL_ISSUE(blk + 3);
                asm volatile("s_waitcnt vmcnt(12)" ::: "memory");
#pragma unroll
                for (int jj = 0; jj < 2; ++jj) { const int tile = 8 * (2 * blk + jj) + wid;
                    u32x4 k0, k1; ds_read_b128_x2(k0, k1, ra0, ra1, ((blk & 3) * 2 + jj) * 2048);
                    f32x4 acc = __builtin_amdgcn_mfma_f32_16x16x32_bf16(aq[0], __builtin_bit_cast(bf16x8, k0), (f32x4){0.f, 0.f, 0.f, 0.f}, 0, 0, 0);
                    acc = __builtin_amdgcn_mfma_f32_16x16x32_bf16(aq[1], __builtin_bit_cast(bf16x8, k1), acc, 0, 0, 0);
                    float sc = w4[0] * relu_(acc[0]) + w4[1] * relu_(acc[1]) + w4[2] * relu_(acc[2]) + w4[3] * relu_(acc[3]);
                    sc += 0.0f;
                    const unsigned bits = __float_as_uint(sc); const unsigned mono = bits ^ ((bits >> 31) ? 0xFFFFFFFFu : 0x80000000u);
                    const unsigned kv = (16 * tile + n <= tq) ? mono : 0u; mk[2 * blk + jj] = kv; m2 = max(m2, min(m1, kv)); m1 = max(m1, kv); }
            } else { mk[2 * blk] = 0u; mk[2 * blk + 1] = 0u; }
        }
#undef SEL_ISSUE
        asm volatile("s_waitcnt vmcnt(0)" ::: "memory");
        __syncthreads();
        int lane_b = 16 * gq + n, wid_b = __builtin_amdgcn_readfirstlane(wid); asm volatile("" : "+v"(lane_b), "+s"(wid_b));
        const int tid_b = wid_b * 64 + lane_b;
        LAS unsigned* hq = hist + gq * 4096;
#define SEL_ZERO_HIST() do { const u32x4 z = (u32x4){0u, 0u, 0u, 0u}; _Pragma("unroll") for (int i = 0; i < 8; ++i) *(LAS u32x4*)(hist + (i * NTHREADS + tid_b) * 4) = z; } while (0)
        unsigned lbound;
        {
          m2 = row_min_all(m2); m1 = row_max_all(m1);
          if (n == 0) { ctl[8 + wid * 4 + gq] = m2; ctl[64 + wid * 4 + gq] = m1; }
          if (tid_b < 24) ctl[40 + tid_b] = 0u;
          { const u32x4 z = (u32x4){0u, 0u, 0u, 0u};
#pragma unroll
            for (int i = 0; i < 8; ++i) *(LAS u32x4*)(lds + 65536 + (i * NTHREADS + tid_b) * 16) = z;
            *(LAS u32x4*)(lds + 133632 + tid_b * 16) = z; }
          __syncthreads();
          unsigned lb2 = ctl[8 + gq];
#pragma unroll
          for (int w = 1; w < NWAVES; ++w) lb2 = min(lb2, ctl[8 + w * 4 + gq]);
          lbound = lb2; }
        constexpr int LCAP = 2048;
        LAS unsigned* lc = ctl + 40; LAS unsigned* tief = ctl + 48; LAS unsigned short* selt = (LAS unsigned short*)(lds + 131584);
        { const unsigned lb1 = max(lbound, 1u);
          unsigned cnt = 0u;
#pragma unroll
          for (int jb = 0; jb < 16; ++jb) { if (8 * jb < nj) {
#pragma unroll
              for (int jj = 0; jj < 8; ++jj) cnt += (mk[8 * jb + jj] >= lb1) ? 1u : 0u; } }
          const unsigned incl = row_incl_scan(cnt);
          unsigned base = 0u;
          if (n == 15) base = __hip_atomic_fetch_add(lc + gq, incl, __ATOMIC_RELAXED, __HIP_MEMORY_SCOPE_WORKGROUP);
          base = row_max_all(base);
          const unsigned lbw = (base + incl > (unsigned)LCAP) ? 0xFFFFFFFFu : lb1;
          LAS u32x2* wp = (LAS u32x2*)(lds + gq * (LCAP * 8)) + (base + incl - cnt);
#pragma unroll
          for (int jb = 0; jb < 16; ++jb) { if (8 * jb < nj) {
#pragma unroll
              for (int jj = 0; jj < 8; ++jj) { const int j = 8 * jb + jj; const unsigned v = mk[j];
                  if (v >= lbw) { unsigned vv = v; asm volatile("" : "+v"(vv));
                      *wp = (u32x2){vv, (unsigned)(16 * (8 * j + wid) + n)}; ++wp; } }
              asm volatile("" ::: "memory"); } } }
        __syncthreads();
        const bool overflow = (lc[0] > (unsigned)LCAP) || (lc[1] > (unsigned)LCAP) || (lc[2] > (unsigned)LCAP) || (lc[3] > (unsigned)LCAP);
        if (!overflow) {
            int lane_c = lane_b, wid_c = __builtin_amdgcn_readfirstlane(wid_b); asm volatile("" : "+v"(lane_c), "+s"(wid_c));
            const int q = wid_c >> 1, r = ((wid_c & 1) << 6) | lane_c; const unsigned nq = (unsigned)__builtin_amdgcn_readfirstlane((int)lc[q]);
            LAS unsigned* ha = (LAS unsigned*)(lds + 65536) + q * 2048; LAS unsigned* hb = (LAS unsigned*)(lds + 98304) + q * 2048;
            u32x2 ent[16];
            const bool big = nq > 1024u;
#define SEL_FOR_ENT(...) do { _Pragma("unroll") for (int i = 0; i < 8; ++i) { __VA_ARGS__ } if (big) { _Pragma("unroll") for (int i = 8; i < 16; ++i) { __VA_ARGS__ } } } while (0)
            { const LAS unsigned char* lq = lds + q * (LCAP * 8);
#pragma unroll
              for (int i = 8; i < 16; ++i) ent[i] = (u32x2){0u, 0u};
              SEL_FOR_ENT(const u32x2 t = *(const LAS u32x2*)(lq + (128 * i + r) * 8); ent[i].x = ((unsigned)(128 * i + r) < nq) ? t.x : 0u; ent[i].y = t.y;); }
            unsigned lbq = ctl[8 + q], vmax = ctl[64 + q];
#pragma unroll
            for (int w = 1; w < NWAVES; ++w) { lbq = min(lbq, ctl[8 + w * 4 + q]); vmax = max(vmax, ctl[64 + w * 4 + q]); }
            lbq = max(lbq, 1u) - 1u;
            SEL_FOR_ENT(ent[i].x = (ent[i].x != 0u) ? ent[i].x - lbq : 0u;);
            const int nbits = 32 - __builtin_clz(vmax - lbq);
            const int s0 = max(nbits - 11, 0), s1 = max(s0 - 11, 0);
            unsigned pref = 0u, need = (unsigned)TOPK;
            SEL_FOR_ENT(const unsigned v = ent[i].x; if (v != 0u) __hip_atomic_fetch_add(ha + sel_bin<5>(v >> s0), 1u, __ATOMIC_RELAXED, __HIP_MEMORY_SCOPE_WORKGROUP););
            __syncthreads();
            if ((wid & 1) == 0) sel_find_bin<5>(ha, need, ctl + 2 * q, ctl + 52 + q, (LAS unsigned*)nullptr, lane);
            __syncthreads();
            pref = ctl[2 * q]; need = ctl[2 * q + 1];
#pragma unroll
            for (int k = 0; k < 4; ++k) *(LAS u32x4*)(ha + (k * 128 + r) * 4) = (u32x4){0u, 0u, 0u, 0u};
            SEL_FOR_ENT(const unsigned v = ent[i].x; if (v != 0u && (v >> s0) == pref) __hip_atomic_fetch_add(hb + sel_bin<5>((v >> s1) & ((1u << (s0 - s1)) - 1u)), 1u, __ATOMIC_RELAXED, __HIP_MEMORY_SCOPE_WORKGROUP););
            __syncthreads();
            if ((wid & 1) == 0) sel_find_bin<5>(hb, need, ctl + 2 * q, ctl + 52 + q, (LAS unsigned*)nullptr, lane);
            __syncthreads();
            pref = (pref << (s0 - s1)) | ctl[2 * q]; need = ctl[2 * q + 1];
            SEL_FOR_ENT(const unsigned v = ent[i].x; if (v != 0u && (v >> s1) == pref) __hip_atomic_fetch_add(ha + sel_bin<4>(v & ((1u << s1) - 1u)), 1u, __ATOMIC_RELAXED, __HIP_MEMORY_SCOPE_WORKGROUP););
            __syncthreads();
            if ((wid & 1) == 0) sel_find_bin<4>(ha, need, ctl + 2 * q, ctl + 52 + q, tief, lane);
            __syncthreads();
            pref = (pref << s1) | ctl[2 * q]; need = ctl[2 * q + 1];
            const unsigned tau = pref, needE = need, nE = ctl[52 + q];
            unsigned thrR = 0u;
            if (*tief) {
                unsigned prefR = 0u, needR = needE;
#pragma unroll
                for (int lvl = 0; lvl < 2; ++lvl) {
                    if (r < 32) *(LAS u32x4*)(ha + r * 4) = (u32x4){0u, 0u, 0u, 0u};
                    __syncthreads();
                    SEL_FOR_ENT(if (ent[i].x == tau) { const unsigned kr = 16383u - ent[i].y;
                        if (lvl == 0 || (kr >> 7) == prefR) __hip_atomic_fetch_add(ha + sel_bin<1>(lvl == 0 ? (kr >> 7) : (kr & 127u)), 1u, __ATOMIC_RELAXED, __HIP_MEMORY_SCOPE_WORKGROUP); });
                    __syncthreads();
                    if ((wid & 1) == 0) sel_find_bin<1>(ha, needR, ctl + 2 * q, (LAS unsigned*)nullptr, (LAS unsigned*)nullptr, lane);
                    __syncthreads();
                    prefR = (prefR << 7) | ctl[2 * q]; needR = ctl[2 * q + 1];
                }
                thrR = (nE > needE) ? prefR : 0u;
            }
            LAS unsigned* bm = (LAS unsigned*)(lds + 133632) + q * 512;
            SEL_FOR_ENT(const unsigned v = ent[i].x; const unsigned ix = ent[i].y;
                if (v > tau || (v == tau && (16383u - ix) >= thrR)) __hip_atomic_fetch_or(bm + (ix >> 5), 1u << (ix & 31u), __ATOMIC_RELAXED, __HIP_MEMORY_SCOPE_WORKGROUP););
            __syncthreads();
            { const u32x4 w = *(const LAS u32x4*)(bm + 4 * r);
              const unsigned c = (unsigned)(__popc(w.x) + __popc(w.y) + __popc(w.z) + __popc(w.w));
              const unsigned incl = wave_incl_scan(c);
              if (lane_c == 63) ctl[56 + wid_c] = incl;
              __syncthreads();
              unsigned pos = incl - c + ((wid_c & 1) ? ctl[56 + wid_c - 1] : 0u);
              LAS unsigned short* st = selt + q * TOPK;
#pragma unroll
              for (int k = 0; k < 4; ++k) { unsigned ww = w[k];
                  while (ww) { const unsigned bpos = (unsigned)__builtin_ctz(ww); if (pos < (unsigned)TOPK) st[pos] = (unsigned short)(128 * r + 32 * k + bpos); ++pos; ww &= ww - 1u; } }
              __syncthreads();
              *(unsigned*)(p->sel + (mq0 + q) * TOPK + 2 * r) = *(const LAS unsigned*)(st + 2 * r); }
#undef SEL_FOR_ENT
            continue;
        }
        SEL_ZERO_HIST();
        __syncthreads();
        unsigned pref = 0u, need = (unsigned)TOPK;
#pragma unroll
        for (int lvl = 0; lvl < 3; ++lvl) {
            const int sh = lvl == 0 ? 20 : (lvl == 1 ? 8 : 0), nb = lvl == 2 ? 8 : 12;
            if (lvl > 0) { __syncthreads(); SEL_ZERO_HIST(); __syncthreads(); }
#pragma unroll
            for (int jb = 0; jb < 16; ++jb) { if (8 * jb < nj) {
#pragma unroll
                for (int jj = 0; jj < 8; ++jj) { const unsigned v = mk[8 * jb + jj];
                    const bool in = (lvl == 0) ? (v != 0u && v >= lbound) : ((v >> (sh + nb)) == pref);
                    if (in) { const unsigned d = (v >> sh) & ((1u << nb) - 1u); __hip_atomic_fetch_add(hq + SEL_BIN(d), 1u, __ATOMIC_RELAXED, __HIP_MEMORY_SCOPE_WORKGROUP); } }
                asm volatile("" ::: "memory"); } }
            __syncthreads();
            if (wid < 4) { const unsigned nq = (unsigned)__builtin_amdgcn_readlane((int)need, 16 * wid);
                sel_find_bin<6>(hist + wid * 4096, nq, ctl + 2 * wid, (LAS unsigned*)nullptr, (LAS unsigned*)nullptr, lane); }
            __syncthreads();
            pref = (pref << nb) | ctl[2 * gq]; need = ctl[2 * gq + 1];
        }
#undef SEL_ZERO_HIST
        const unsigned tau = pref, needE = need;
        { const u32x4 z = (u32x4){0u, 0u, 0u, 0u}; *(LAS u32x4*)(cntG + tid_b * 8) = z; *(LAS u32x4*)(cntG + 4096 + tid_b * 8) = z; }
        __syncthreads();
#pragma unroll
        for (int jb = 0; jb < 16; ++jb) { if (8 * jb < nj) {
#pragma unroll
            for (int jj = 0; jj < 8; ++jj) { const int j = 8 * jb + jj; const unsigned v = mk[j];
                const unsigned long long bg = __ballot(v > tau), be = __ballot(v == tau);
                if ((bg | be) && n == 0) { const int tile = 8 * j + wid; cntG[gq * 1024 + tile] = (unsigned short)__popc((unsigned)(bg >> (16 * gq)) & 0xffffu); cntE[gq * 1024 + tile] = (unsigned short)__popc((unsigned)(be >> (16 * gq)) & 0xffffu); } }
            asm volatile("" ::: "memory"); } }
        __syncthreads();
        { LAS unsigned short* cp = (wid < 4 ? cntG : cntE) + (wid & 3) * 1024 + 16 * lane;
          const u32x4 a = *(const LAS u32x4*)cp, c2 = *(const LAS u32x4*)(cp + 8);
          unsigned v[16] = {a.x & 0xffffu, a.x >> 16, a.y & 0xffffu, a.y >> 16, a.z & 0xffffu, a.z >> 16, a.w & 0xffffu, a.w >> 16, c2.x & 0xffffu, c2.x >> 16, c2.y & 0xffffu, c2.y >> 16, c2.z & 0xffffu, c2.z >> 16, c2.w & 0xffffu, c2.w >> 16};
          unsigned tot = 0;
#pragma unroll
          for (int i = 0; i < 16; ++i) { const unsigned t = v[i]; v[i] = tot; tot += t; }
          const unsigned incl = wave_incl_scan(tot);
          const unsigned base = incl - tot;
          u32x4 o0, o1;
          o0.x = (v[0] + base) | ((v[1] + base) << 16); o0.y = (v[2] + base) | ((v[3] + base) << 16); o0.z = (v[4] + base) | ((v[5] + base) << 16); o0.w = (v[6] + base) | ((v[7] + base) << 16);
          o1.x = (v[8] + base) | ((v[9] + base) << 16); o1.y = (v[10] + base) | ((v[11] + base) << 16); o1.z = (v[12] + base) | ((v[13] + base) << 16); o1.w = (v[14] + base) | ((v[15] + base) << 16);
          *(LAS u32x4*)cp = o0; *(LAS u32x4*)(cp + 8) = o1; }
        __syncthreads();
        { unsigned tau2 = tau; asm volatile("" : "+v"(tau2));
          bf16_t* so = p->sel + (mq0 + gq) * TOPK; const unsigned below = (1u << n) - 1u; const unsigned cG = (unsigned)TOPK - needE;
#pragma unroll
          for (int jb = 0; jb < 16; ++jb) { if (8 * jb < nj) {
#pragma unroll
              for (int jj = 0; jj < 8; ++jj) { const int j = 8 * jb + jj; const unsigned v = mk[j];
                  const bool isg = v > tau2, ise = v == tau2;
                  const unsigned long long bg = __ballot(isg), be = __ballot(ise);
                  if (bg | be) { const int tile = 8 * j + wid;
                      const unsigned mg = (unsigned)(bg >> (16 * gq)) & 0xffffu, me = (unsigned)(be >> (16 * gq)) & 0xffffu;
                      if (isg) { const unsigned slot = cntG[gq * 1024 + tile] + __popc(mg & below); so[slot] = (bf16_t)(16 * tile + n); }
                      else if (ise) { const unsigned rank = cntE[gq * 1024 + tile] + __popc(me & below); if (rank < needE) so[cG + rank] = (bf16_t)(16 * tile + n); } } }
              asm volatile("" ::: "memory"); } } }
        __syncthreads();
    }
}

enum { PH_PRO = 0, PH_XKV, PH_INPROJ, PH_SELECT, PH_MIX, PH_FINISH, PH_GATES, PH_OUT, PH_NORM1, PH_XQ, PH_XS, PH_XSM, PH_XPV, PH_XO, PH_NORM2, PH_GU, PH_DOWN, PH_NORM3, PH_COUNT };

template <int ONLY>
__device__ __forceinline__ void layer_body(KP p, const int l, LAS unsigned char* lds, const XcdBarrier& bar) {
#define RUN(ph) (ONLY < 0 || ONLY == (ph))
#define SYNC() do { if (ONLY < 0) xcd_barrier(bar); } while (0)
    StaticOrder so;

        const bf16_t* wl = p->wt + (size_t)l * WT_LAYER;
        const float* xin = (l == 0) ? p->x : p->out;
        bf16_t* RQ = p->raw; bf16_t* RK = p->raw + (size_t)MTOK * 1024; bf16_t* RV = p->raw + (size_t)MTOK * 2048;
        if (RUN(PH_INPROJ)) { Gemm g = pg8::make_gemm(p->xn, wl + WT_IN, MTOK, 5120, 1024); so.init(MTOK, 5120, gridDim.x, blockIdx.x); pg8::gemm_phase(lds, g, so, EpiInProj{p, l}); }
        SYNC();
        if (RUN(PH_SELECT)) { phase_gdn_prep(p, l, lds); __syncthreads(); phase_dsa_select(p, lds); }
        SYNC();
        if (RUN(PH_MIX)) {
            const int tid_ = tid_opaque(); const int wid_ = __builtin_amdgcn_readfirstlane(tid_ >> 6), lane_ = tid_ & 63;
            volatile LAS unsigned* sflag = (volatile LAS unsigned*)(lds + LDS_BYTES - 48);
            volatile LAS unsigned* f_dma = (volatile LAS unsigned*)(lds + LDS_BYTES - 64); volatile LAS unsigned* f_vr = f_dma + 1; volatile LAS unsigned* f_done = f_dma + 2;
            const unsigned fbase = 256u * (unsigned)l;
            const unsigned qx_ = blockIdx.x & 31u; unsigned* ctr = p->bar + XCD_BAR_WORDS + 64 + 24576 + (l * 32 + (int)qx_) * 16;
            if (blockIdx.x < 128) {
                if (wid_ == 0) { __builtin_amdgcn_s_setprio(1); gdn_scan_unit(p, blockIdx.x, lds, lane_, f_vr, f_done, fbase); __builtin_amdgcn_s_setprio(0);
                    asm volatile("s_waitcnt vmcnt(0) lgkmcnt(0)" ::: "memory"); *sflag = (unsigned)(l + 1); }
                else if (wid_ <= 5) phase_sparse_attn<false>(p, ctr, qx_, lds + SC_END + (wid_ - 1) * 8192, lane_);
                else { if (wid_ == 6) gdn_scan_issuer(p, l, blockIdx.x, lds, lane_, f_dma, f_done, fbase); else gdn_scan_conv(p, l, blockIdx.x, lds, lane_, f_dma, f_vr, f_done, fbase);
                    { unsigned sp_ = 0; while (*sflag < (unsigned)(l + 1) && ++sp_ < SC_SPIN_CAP) __builtin_amdgcn_s_sleep(32); }
                    phase_sparse_attn<true>(p, ctr, qx_, lds + (wid_ - 5) * SA_LDS_WAVE, lane_); }
            } else phase_sparse_attn<true>(p, ctr, qx_, lds + wid_ * SA_LDS_WAVE, lane_);
        }
        SYNC();
        if (RUN(PH_GATES)) { Gemm g = pg8::make_gemm(p->xn, wl + WT_GATE, MTOK, 2048, 1024); so.init(MTOK, 2048, gridDim.x, blockIdx.x); pg8::gemm_phase(lds, g, so, EpiGates{RQ, p->qb, RV, p->gdn_norm + l * 128, lds + 131072}); }
        if (l == 0 && RUN(PH_XKV)) {
            Gemm g = pg8::make_gemm(p->memn, p->wt + WT_XKV, 1024, 2048, 1024); g.bat_div = 2; g.b_bat = WT_LAYER;
            so.init(1024, 2048, gridDim.x, blockIdx.x); pg8::gemm_phase(lds, g, so, EpiXKV{p->xk, p->xvt});
        }
        SYNC();
        if (RUN(PH_OUT)) { Gemm g = pg8::make_gemm(RQ, wl + WT_OUT, MTOK, 1024, 1024); so.init(MTOK, 1024, gridDim.x, blockIdx.x);
            pg8::gemm_phase(lds, g, so, EpiNormFused{xin, p->out, p->xn, p->norm_mix_post + l * 1024, p->norm_x_pre + l * 1024, p->npart, p->bar + XCD_BAR_WORDS + 64 + ((l * 3 + 0) * 2) * 128 * 16, lds + 131072}); }
        SYNC();
        if (RUN(PH_XQ)) { Gemm g = pg8::make_gemm(p->xn, wl + WT_XQ, MTOK, 1024, 1024); so.init(MTOK, 1024, gridDim.x, blockIdx.x); pg8::gemm_phase(lds, g, so, EpiPlain{p->qb, 1024, 0.0625f}); }
        if (ONLY < 0) __syncthreads();
        if (RUN(PH_XS)) {
            Gemm g = pg8::make_gemm(p->qb, p->xk + (size_t)l * 512 * 1024, MTOK, 1024, 256); g.lda = 1024; g.ldb = 1024; g.a_pn = 256; g.b_pn = 256; g.bat_div = 64; g.b_bat = 256l * 1024;
            so.init(MTOK, 1024, gridDim.x, blockIdx.x); pg8::gemm_phase(lds, g, so, EpiSoftmaxP{RV, lds + 131072});
        }
        if (ONLY < 0) __syncthreads();
        if (RUN(PH_XPV)) {
            Gemm g = pg8::make_gemm(RV, p->xvt + (size_t)l * 2 * 4 * 65536, MTOK, 1024, 256); g.lda = 1024; g.ldb = 256; g.a_pn = 256; g.b_pn = 65536; g.bat_div = 64; g.b_bat = 4l * 65536;
            so.init(MTOK, 1024, gridDim.x, blockIdx.x); pg8::gemm_phase(lds, g, so, EpiPlain{p->xn, 1024, 1.0f});
        }
        SYNC();
        if (RUN(PH_XO)) { Gemm g = pg8::make_gemm(p->xn, wl + WT_XO, MTOK, 1024, 1024); so.init(MTOK, 1024, gridDim.x, blockIdx.x);
            pg8::gemm_phase(lds, g, so, EpiNormFused{p->out, p->out, p->xn, p->norm_x_post + l * 1024, p->norm_ffn_pre + l * 1024, p->npart, p->bar + XCD_BAR_WORDS + 64 + ((l * 3 + 1) * 2) * 128 * 16, lds + 131072}); }
        SYNC();
        if (RUN(PH_GU)) { Gemm g = pg8::make_gemm(p->xn, wl + WT_GU, MTOK, 5632, 1024); so.init(MTOK, 5632, gridDim.x, blockIdx.x); pg8::gemm_phase(lds, g, so, EpiSwiGLU{p->raw}); }
        SYNC();
        if (RUN(PH_DOWN)) { Gemm g = pg8::make_gemm(p->raw, wl + WT_DOWN, MTOK, 1024, 2816); so.init(MTOK, 1024, gridDim.x, blockIdx.x);
            pg8::gemm_phase(lds, g, so, EpiNormFused{p->out, p->out, p->xn, p->norm_ffn_post + l * 1024, (l + 1 < DEPTH) ? p->norm_mix_pre + (l + 1) * 1024 : nullptr, p->npart, p->bar + XCD_BAR_WORDS + 64 + ((l * 3 + 2) * 2) * 128 * 16, lds + 131072}); }
        SYNC();

#undef RUN
#undef SYNC
}

template <int ONLY>
__global__ void __launch_bounds__(NTHREADS, 2) fwd_kernel(Params p_unused, int layer_only) {
    KP p = (KP)__builtin_amdgcn_kernarg_segment_ptr();
    extern __shared__ __attribute__((aligned(16))) unsigned char shm[];
    LAS unsigned char* lds = (LAS unsigned char*)shm;
    volatile LAS unsigned* xbw = (volatile LAS unsigned*)(lds + LDS_BYTES - 16);
    XcdBarrier bar;
    if (ONLY < 0) {
        if (threadIdx.x == 0) { xbw[0] = 0u; xbw[1] = 0u; xbw[2] = 0u; xbw[3] = 0u; xbw[-8] = 0u; xbw[-12] = 0u; xbw[-11] = 0u; xbw[-10] = 0u; }
        __syncthreads();
        bar = xcd_barrier_post(p->bar, xbw);
    }
#define RUN(ph) (ONLY < 0 || ONLY == (ph))
#define SYNC() do { if (ONLY < 0) xcd_barrier(bar); } while (0)
    StaticOrder so;
    if (RUN(PH_PRO)) { phase_prologue(p, lds); }
    SYNC();
    if (ONLY < 0) { layer_body<ONLY>(p, 0, lds, bar); layer_body<ONLY>(p, 1, lds, bar); } else { layer_body<ONLY>(p, layer_only, lds, bar); }
#undef RUN
#undef SYNC
}

static inline size_t align_up(size_t v, size_t a) { return (v + a - 1) / a * a; }

extern "C" void kernel_launch(void* const* d_in, const int* in_sizes, int n_in, void* d_out, int out_size, void* d_ws, size_t ws_size, hipStream_t stream) {
    (void)in_sizes; (void)n_in; (void)out_size;
    Params p;
    memset(&p, 0, sizeof(p));
    p.x = (const float*)d_in[0]; p.mem = (const float*)d_in[1]; p.positions = (const int*)d_in[2];
    p.norm_mix_pre = (const float*)d_in[3]; p.w_in = (const float*)d_in[4]; p.conv_w = (const float*)d_in[5]; p.a_log = (const float*)d_in[6]; p.dt_bias = (const float*)d_in[7];
    p.gdn_norm = (const float*)d_in[8]; p.w_out = (const float*)d_in[9]; p.norm_mix_post = (const float*)d_in[10]; p.norm_x_pre = (const float*)d_in[11]; p.norm_mem = (const float*)d_in[12];
    p.w_xq = (const float*)d_in[13]; p.w_xkv = (const float*)d_in[14]; p.w_xo = (const float*)d_in[15]; p.norm_x_post = (const float*)d_in[16]; p.norm_ffn_pre = (const float*)d_in[17];
    p.w_gu = (const float*)d_in[18]; p.w_down = (const float*)d_in[19]; p.norm_ffn_post = (const float*)d_in[20];
    p.out = (float*)d_out;
    char* w = (char*)d_ws; size_t off = 0;
    auto take = [&](size_t bytes) { char* r = w + off; off = align_up(off + bytes, 256); return r; };
    p.bar = (unsigned*)take((XCD_BAR_WORDS + 64 + 24576 + 1024) * 4);
    constexpr size_t TA_BYTES = (size_t)4096 * 8192 * 2, TA_DEAD = (size_t)2 * 512 * 1024 * 2 + (size_t)2 * MTOK * 64 * 4 + (size_t)WT_LAYER * 2;
    static_assert(TA_DEAD < TA_BYTES && (TA_BYTES - TA_DEAD) % 256 == 0 && ((size_t)WT_LAYER * 2) % 256 == 0, "overlay arithmetic");
    p.ta = (bf16_t*)take(TA_BYTES - TA_DEAD);
    p.memn = (bf16_t*)take((size_t)2 * 512 * 1024 * 2);
    p.rope_cos = (float*)take((size_t)MTOK * 64 * 4); p.rope_sin = (float*)take((size_t)MTOK * 64 * 4);
    p.wt = (bf16_t*)take((size_t)2 * WT_LAYER * 2);
    p.xk = (bf16_t*)take((size_t)2 * 512 * 1024 * 2); p.xvt = (bf16_t*)take((size_t)2 * 2 * 4 * 65536 * 2);
    p.xn = (bf16_t*)take((size_t)MTOK * 1024 * 2); p.qb = (bf16_t*)take((size_t)MTOK * 1024 * 2);
    p.kb = (bf16_t*)take((size_t)MTOK * 256 * 2); p.vb = (bf16_t*)take((size_t)MTOK * 256 * 2); p.qib = (bf16_t*)take((size_t)MTOK * 256 * 2); p.kib = (bf16_t*)take((size_t)MTOK * 64 * 2);
    p.wi = (float*)take((size_t)MTOK * 4 * 4); p.gg = (float*)take((size_t)MTOK * 8 * 4); p.beta = (float*)take((size_t)MTOK * 8 * 4);
    p.raw = (bf16_t*)take((size_t)MTOK * 3072 * 2); p.sel = (bf16_t*)take((size_t)MTOK * TOPK * 2);
    p.halo = (bf16_t*)take((size_t)(MTOK / 64) * 3 * 2048 * 2);
    p.npart = (float*)take((size_t)2 * MTOK * 4 * 4);
    if ((size_t)((char*)(p.wt + WT_LAYER) - (char*)p.ta) < TA_BYTES) { fprintf(stderr, "kernel_launch: overlay span too short\n"); return; }
    if (off > ws_size) { fprintf(stderr, "kernel_launch: workspace too small: need %zu have %zu\n", off, ws_size); return; }

    static int grid = 0;
    if (!grid) {
        int dev = 0, cus = 0, per_cu = 0;
        (void)hipGetDevice(&dev); (void)hipDeviceGetAttribute(&cus, hipDeviceAttributeMultiprocessorCount, dev);
        if (hipFuncSetAttribute((const void*)fwd_kernel<-1>, hipFuncAttributeMaxDynamicSharedMemorySize, LDS_BYTES) != hipSuccess) { fprintf(stderr, "kernel_launch: hipFuncSetAttribute failed\n"); grid = -1; return; }
        if (hipOccupancyMaxActiveBlocksPerMultiprocessor(&per_cu, (const void*)fwd_kernel<-1>, NTHREADS, LDS_BYTES) != hipSuccess || per_cu < 1) fprintf(stderr, "kernel_launch: occupancy query reports %d\n", per_cu);
        grid = cus > 0 ? cus : 256;
        if (grid > 256) grid = 256;
    }
    if (grid <= 0) return;
    (void)hipMemsetAsync(p.bar, 0, (XCD_BAR_WORDS + 64 + 24576 + 1024) * sizeof(unsigned), stream);
    hipLaunchKernelGGL(fwd_kernel<-1>, dim3(grid), dim3(NTHREADS), LDS_BYTES, stream, p, 0);
}
```
